# Optimizing an MI355X kernel written in HIP

```python
import math
import jax, jax.numpy as jnp
from jax import lax
import numpy as np

D_MODEL = 1024
BATCH = 8
SEQ = 4096
DEPTH = 4

GRID_W = 64
CTX_LEN = 256
D_FOURIER = D_MODEL // 2
FOURIER_GROUPS = 4
FOURIER_GROUP_DIM = D_FOURIER // FOURIER_GROUPS
D_SSM = D_MODEL // 2
SSM_GROUP_DIM = 16
SSM_GROUPS = D_SSM // SSM_GROUP_DIM
SSM_STATE = 64
D_FF = ((8 * D_MODEL // 3 + 127) // 128) * 128
N_MOD = 9
D_PROJ = D_FOURIER + D_SSM + 2 * D_MODEL
RMS_EPS = 1e-6
DT_MIN = 1e-3
DT_MAX = 1e-1

kernel_name = "fnet_s5_macaron_gated_hybrid_dit"


def rms_norm(h, g):
    h32 = h.astype(jnp.float32)
    y = h32 * lax.rsqrt(jnp.mean(h32 * h32, axis=-1, keepdims=True) + RMS_EPS)
    return (y * g.astype(jnp.float32)).astype(h.dtype)


def modulated_norm(h, g, shift, scale):
    return rms_norm(h, g) * (1 + scale) + shift


def swiglu(h, w13, w2):
    a, b = jnp.split(h @ w13, 2, axis=-1)
    return (jax.nn.silu(a) * b) @ w2


def half_ffn(h, g, shift, scale, gate, w13, w2):
    return h + 0.5 * gate * swiglu(modulated_norm(h, g, shift, scale), w13, w2)


def fourier_mix(u):
    bsz, t, _ = u.shape
    ug = u.astype(jnp.float32).reshape(bsz, t, FOURIER_GROUPS, FOURIER_GROUP_DIM)
    yg = jnp.fft.fft2(ug, axes=(1, 3), norm="ortho").real
    return yg.reshape(bsz, t, D_FOURIER).astype(u.dtype)


def complex_mul(ar, ai, br, bi):
    return ar * br - ai * bi, ar * bi + ai * br


def ssm_discretise(lam_re, lam_im, log_step, b_re, b_im):
    f32 = jnp.float32
    lam_re = lam_re.astype(f32)
    lam_im = lam_im.astype(f32)
    dt = jnp.exp(log_step.astype(f32))[:, None]
    mag = jnp.exp(lam_re * dt)
    lb_re = mag * jnp.cos(lam_im * dt)
    lb_im = mag * jnp.sin(lam_im * dt)
    den = lam_re * lam_re + lam_im * lam_im
    nr = lb_re - 1.0
    ni = lb_im
    k_re = (nr * lam_re + ni * lam_im) / den
    k_im = (ni * lam_re - nr * lam_im) / den
    b_re = b_re.astype(f32)
    b_im = b_im.astype(f32)
    bb_re = k_re[..., None] * b_re - k_im[..., None] * b_im
    bb_im = k_re[..., None] * b_im + k_im[..., None] * b_re
    return lb_re, lb_im, bb_re, bb_im


def _scan_combine(e1, e2):
    a1r, a1i, b1r, b1i = e1
    a2r, a2i, b2r, b2i = e2
    ar, ai = complex_mul(a1r, a1i, a2r, a2i)
    br, bi = complex_mul(a2r, a2i, b1r, b1i)
    return ar, ai, br + b2r, bi + b2i


def ssm_scan(u, disc, h0, reverse):
    lb_re, lb_im, bb_re, bb_im = disc
    bu_re = jnp.einsum("btgh,gph->btgp", u, bb_re)
    bu_im = jnp.einsum("btgh,gph->btgp", u, bb_im)
    if h0 is not None:
        edge = -1 if reverse else 0
        ir, ii = complex_mul(lb_re, lb_im, h0[0], h0[1])
        bu_re = bu_re.at[:, edge].add(ir)
        bu_im = bu_im.at[:, edge].add(ii)
    t = u.shape[1]
    a_re = jnp.broadcast_to(lb_re, (1, t, SSM_GROUPS, SSM_STATE))
    a_im = jnp.broadcast_to(lb_im, (1, t, SSM_GROUPS, SSM_STATE))
    _, _, s_re, s_im = lax.associative_scan(
        _scan_combine, (a_re, a_im, bu_re, bu_im), reverse=reverse, axis=1)
    return s_re, s_im


def ssm_readout(s_re, s_im, c_re, c_im):
    c_re = c_re.astype(jnp.float32)
    c_im = c_im.astype(jnp.float32)
    return (jnp.einsum("btgp,ghp->btgh", s_re, c_re)
            - jnp.einsum("btgp,ghp->btgh", s_im, c_im))


def bidirectional_ssm(u_ctx, u_lat, lam_re, lam_im, log_step, b_re, b_im, c_re, c_im, d,
                      with_ctx_output):
    bsz = u_lat.shape[0]
    uc = u_ctx.astype(jnp.float32).reshape(bsz, -1, SSM_GROUPS, SSM_GROUP_DIM)
    ul = u_lat.astype(jnp.float32).reshape(bsz, -1, SSM_GROUPS, SSM_GROUP_DIM)
    dg = d.astype(jnp.float32).reshape(SSM_GROUPS, SSM_GROUP_DIM)
    y_lat = dg * ul
    y_ctx = dg * uc if with_ctx_output else None
    for direction, reverse in ((0, False), (1, True)):
        disc = ssm_discretise(lam_re[direction], lam_im[direction], log_step[direction],
                              b_re[direction], b_im[direction])
        sc_re, sc_im = ssm_scan(uc, disc, None, reverse)
        edge = 0 if reverse else -1
        h0 = (sc_re[:, edge], sc_im[:, edge])
        sl_re, sl_im = ssm_scan(ul, disc, h0, reverse)
        y_lat = y_lat + ssm_readout(sl_re, sl_im, c_re[direction], c_im[direction])
        if with_ctx_output:
            y_ctx = y_ctx + ssm_readout(sc_re, sc_im, c_re[direction], c_im[direction])
    y_lat = y_lat.reshape(bsz, -1, D_SSM).astype(u_lat.dtype)
    if with_ctx_output:
        y_ctx = y_ctx.reshape(bsz, -1, D_SSM).astype(u_ctx.dtype)
    return y_ctx, y_lat


def merge_branches(proj, y_ssm, w_fourier_out, w_glu, w_ssm_out, w_out):
    u_f = proj[..., :D_FOURIER]
    g_f = proj[..., D_FOURIER + D_SSM:D_FOURIER + D_SSM + D_MODEL]
    g_s = proj[..., D_FOURIER + D_SSM + D_MODEL:]
    f_branch = fourier_mix(u_f) @ w_fourier_out
    z = jax.nn.gelu(y_ssm)
    za, zg = jnp.split(z @ w_glu, 2, axis=-1)
    s_branch = (za * jax.nn.sigmoid(zg)) @ w_ssm_out
    return (jax.nn.sigmoid(g_f) * f_branch + jax.nn.sigmoid(g_s) * s_branch) @ w_out


def setup_inputs(seed: int = 0) -> dict:
    key = jax.random.key(seed)
    ks = jax.random.split(key, 25)
    f32 = jnp.float32

    def nrm(k, shape, fan_in):
        return jax.random.normal(k, shape, f32) * (fan_in ** -0.5)

    G, P, H = SSM_GROUPS, SSM_STATE, SSM_GROUP_DIM
    x = jax.random.normal(ks[0], (BATCH, SEQ, D_MODEL), f32)
    c = jax.random.normal(ks[1], (BATCH, D_MODEL), f32)
    ctx = jax.random.normal(ks[2], (BATCH, CTX_LEN, D_MODEL), f32)
    c_ctx = jax.random.normal(ks[3], (D_MODEL,), f32)
    w_mod = nrm(ks[4], (DEPTH, D_MODEL, N_MOD * D_MODEL), D_MODEL)
    b_mod = 0.02 * jax.random.normal(ks[5], (DEPTH, N_MOD * D_MODEL), f32)
    norm_g = 1.0 + 0.02 * jax.random.normal(ks[6], (DEPTH, 3, D_MODEL), f32)
    ffn1_w13 = nrm(ks[7], (DEPTH, D_MODEL, 2 * D_FF), D_MODEL)
    ffn1_w2 = nrm(ks[8], (DEPTH, D_FF, D_MODEL), D_FF)
    w_in = nrm(ks[9], (DEPTH, D_MODEL, D_PROJ), D_MODEL)
    w_fourier_out = nrm(ks[10], (DEPTH, D_FOURIER, D_MODEL), D_FOURIER)
    ssm_lambda_re = -0.5 + 0.01 * jax.random.normal(ks[11], (DEPTH, 2, G, P), f32)
    ssm_lambda_im = (math.pi * jnp.arange(P, dtype=f32)
                     + 0.01 * jax.random.normal(ks[12], (DEPTH, 2, G, P), f32))
    ssm_log_step = jax.random.uniform(ks[13], (DEPTH, 2, G), f32,
                                      minval=math.log(DT_MIN), maxval=math.log(DT_MAX))
    ssm_b_re = nrm(ks[14], (DEPTH, 2, G, P, H), 2 * H)
    ssm_b_im = nrm(ks[15], (DEPTH, 2, G, P, H), 2 * H)
    ssm_c_re = nrm(ks[16], (DEPTH, 2, G, H, P), P)
    ssm_c_im = nrm(ks[17], (DEPTH, 2, G, H, P), P)
    ssm_d = jax.random.normal(ks[18], (DEPTH, D_SSM), f32)
    w_glu = nrm(ks[19], (DEPTH, D_SSM, 2 * D_SSM), D_SSM)
    w_ssm_out = nrm(ks[20], (DEPTH, D_SSM, D_MODEL), D_SSM)
    w_out = nrm(ks[21], (DEPTH, D_MODEL, D_MODEL), D_MODEL)
    ffn2_w13 = nrm(ks[22], (DEPTH, D_MODEL, 2 * D_FF), D_MODEL)
    ffn2_w2 = nrm(ks[23], (DEPTH, D_FF, D_MODEL), D_FF)
    final_g = 1.0 + 0.02 * jax.random.normal(ks[24], (D_MODEL,), f32)
    return {"x": x, "c": c, "ctx": ctx, "c_ctx": c_ctx, "w_mod": w_mod, "b_mod": b_mod,
            "norm_g": norm_g, "ffn1_w13": ffn1_w13, "ffn1_w2": ffn1_w2, "w_in": w_in,
            "w_fourier_out": w_fourier_out, "ssm_lambda_re": ssm_lambda_re,
            "ssm_lambda_im": ssm_lambda_im, "ssm_log_step": ssm_log_step,
            "ssm_b_re": ssm_b_re, "ssm_b_im": ssm_b_im, "ssm_c_re": ssm_c_re,
            "ssm_c_im": ssm_c_im, "ssm_d": ssm_d, "w_glu": w_glu, "w_ssm_out": w_ssm_out,
            "w_out": w_out, "ffn2_w13": ffn2_w13, "ffn2_w2": ffn2_w2, "final_g": final_g}


def reference(x, c, ctx, c_ctx, w_mod, b_mod, norm_g, ffn1_w13, ffn1_w2, w_in,
              w_fourier_out, ssm_lambda_re, ssm_lambda_im, ssm_log_step, ssm_b_re,
              ssm_b_im, ssm_c_re, ssm_c_im, ssm_d, w_glu, w_ssm_out, w_out,
              ffn2_w13, ffn2_w2, final_g):
    h_lat = x
    h_ctx = ctx
    silu_c = jax.nn.silu(c)
    silu_cc = jax.nn.silu(c_ctx)
    s5_lo, s5_hi = D_FOURIER, D_FOURIER + D_SSM
    for layer in range(DEPTH):
        last = layer == DEPTH - 1
        m_lat = jnp.split((silu_c @ w_mod[layer] + b_mod[layer])[:, None, :], N_MOD, axis=-1)
        m_ctx = jnp.split(silu_cc @ w_mod[layer] + b_mod[layer], N_MOD, axis=-1)
        g = norm_g[layer]

        h_lat = half_ffn(h_lat, g[0], m_lat[0], m_lat[1], m_lat[2],
                         ffn1_w13[layer], ffn1_w2[layer])
        h_ctx = half_ffn(h_ctx, g[0], m_ctx[0], m_ctx[1], m_ctx[2],
                         ffn1_w13[layer], ffn1_w2[layer])

        p_lat = modulated_norm(h_lat, g[1], m_lat[3], m_lat[4]) @ w_in[layer]
        p_ctx = modulated_norm(h_ctx, g[1], m_ctx[3], m_ctx[4]) @ w_in[layer]
        y_ctx, y_lat = bidirectional_ssm(
            p_ctx[..., s5_lo:s5_hi], p_lat[..., s5_lo:s5_hi],
            ssm_lambda_re[layer], ssm_lambda_im[layer], ssm_log_step[layer],
            ssm_b_re[layer], ssm_b_im[layer], ssm_c_re[layer], ssm_c_im[layer],
            ssm_d[layer], not last)
        h_lat = h_lat + m_lat[5] * merge_branches(p_lat, y_lat, w_fourier_out[layer],
                                                  w_glu[layer], w_ssm_out[layer], w_out[layer])

        h_lat = half_ffn(h_lat, g[2], m_lat[6], m_lat[7], m_lat[8],
                         ffn2_w13[layer], ffn2_w2[layer])
        if not last:
            h_ctx = h_ctx + m_ctx[5] * merge_branches(p_ctx, y_ctx, w_fourier_out[layer],
                                                      w_glu[layer], w_ssm_out[layer], w_out[layer])
            h_ctx = half_ffn(h_ctx, g[2], m_ctx[6], m_ctx[7], m_ctx[8],
                             ffn2_w13[layer], ffn2_w2[layer])
    return rms_norm(h_lat, final_g)
```

```cpp
#include <hip/hip_runtime.h>
#include <hip/hip_cooperative_groups.h>
#include <cstdio>
#include <cstdint>
namespace cg = cooperative_groups;
#ifndef MIXSEL
#define MIXSEL 0xffff
#endif

#define LAS __attribute__((address_space(3)))
typedef unsigned short bf16_t;
typedef short bf16x8 __attribute__((ext_vector_type(8)));
typedef float f32x4 __attribute__((ext_vector_type(4)));
typedef float f32x2 __attribute__((ext_vector_type(2)));
typedef unsigned u32x4 __attribute__((ext_vector_type(4)));
typedef unsigned u32x2 __attribute__((ext_vector_type(2)));

constexpr int DM = 1024, NB = 8, SEQ = 4096, CTX = 256, DEPTH = 4, DFF = 2816;
constexpr int ML = NB * SEQ, MC = NB * CTX, MT = ML + MC;
constexpr int NMOD = 9 * DM;
constexpr int UROWS = 2304;

constexpr size_t MiB = 1u << 20;
constexpr size_t WS_H = 0;
constexpr size_t WS_X = 136 * MiB;
constexpr size_t X_HID = WS_X;
constexpr size_t X_AN_FFN = WS_X + 276 * MiB;
constexpr size_t X_VT2 = WS_X;
constexpr size_t X_VT2C = WS_X + 64 * MiB;
constexpr size_t X_SGF = WS_X + 68 * MiB;
constexpr size_t X_SGS = WS_X + 136 * MiB;
constexpr size_t X_UG = WS_X + 204 * MiB;
constexpr size_t X_S = WS_X + 240 * MiB;
constexpr size_t X_AN_MIX = X_S;
constexpr size_t X_YS = X_S;
constexpr size_t X_ZG = X_S + 34 * MiB;
constexpr size_t X_YF = WS_X + 312 * MiB;
constexpr size_t X_YI = WS_X;
constexpr size_t X_MODP = WS_X;
constexpr size_t WS_DFT = 482 * MiB;
constexpr size_t WS_DFTC = 546 * MiB;
constexpr size_t WS_W = 547 * MiB;
constexpr size_t W_13 = WS_W;
constexpr size_t W_2 = WS_W + 11 * MiB;
constexpr size_t W_IN = WS_W + 17 * MiB;
constexpr size_t W_FO = WS_W + 24 * MiB;
constexpr size_t W_GLU = WS_W + 25 * MiB;
constexpr size_t W_SSO = WS_W + 26 * MiB;
constexpr size_t W_OUT = WS_W + 27 * MiB;
constexpr size_t W_SA = WS_W + 29 * MiB;
constexpr size_t W_SB = WS_W + 37 * MiB;
constexpr size_t WS_MOD = 588 * MiB;
constexpr size_t WS_END = 590 * MiB;

constexpr int LDS_BYTES = 139264;

__device__ __forceinline__ unsigned cvt_pk_bf16(float lo, float hi) { unsigned r; asm volatile("s_nop 1\n\tv_cvt_pk_bf16_f32 %0, %1, %2" : "=v"(r) : "v"(lo), "v"(hi)); return r; }
__device__ __forceinline__ float bf_lo(unsigned w) { return __uint_as_float(w << 16); }
__device__ __forceinline__ float bf_hi(unsigned w) { return __uint_as_float(w & 0xffff0000u); }
__device__ __forceinline__ float sigmoidf_(float x) { return __builtin_amdgcn_rcpf(1.f + __expf(-x)); }
__device__ __forceinline__ float siluf_(float x) { return x * sigmoidf_(x); }
__device__ __forceinline__ float gelu_tanh(float y) { const float u = 0.7978845608028654f * (y + 0.044715f * y * y * y); return y * sigmoidf_(2.f * u); }
__device__ __forceinline__ float wave_sum(float v) {
#pragma unroll
    for (int o = 1; o < 64; o <<= 1) v += __shfl_xor(v, o);
    return v;
}
__device__ __forceinline__ u32x4 pack8(const float (&r)[8]) { u32x4 w; w.x = cvt_pk_bf16(r[0], r[1]); w.y = cvt_pk_bf16(r[2], r[3]); w.z = cvt_pk_bf16(r[4], r[5]); w.w = cvt_pk_bf16(r[6], r[7]); return w; }
__device__ __forceinline__ void unpack8(const u32x4 w, float (&r)[8]) { r[0] = bf_lo(w.x); r[1] = bf_hi(w.x); r[2] = bf_lo(w.y); r[3] = bf_hi(w.y); r[4] = bf_lo(w.z); r[5] = bf_hi(w.z); r[6] = bf_lo(w.w); r[7] = bf_hi(w.w); }

namespace pg8 {
constexpr int BM = 256, BK = 64, HALF = 128, HTB = HALF * BK * 2, STAGE_BYTES = 8 * HTB, NXCD = 8, WGM = 8;
__host__ __device__ __forceinline__ int lds_byte(int r, int c) { const int st = (r >> 4) * 2 + (c >> 5), rr = r & 15, cc = c & 31, ob = rr * 64 + cc * 2; return st * 1024 + (ob ^ (((ob >> 9) & 1) << 5)); }
__host__ __device__ __forceinline__ void stage_rc(int b, int& R, int& C) { const int st = b / 1024, sb = b % 1024, swz = sb ^ (((sb >> 9) & 1) << 5); R = (st >> 1) * 16 + swz / 64; C = (st & 1) * 32 + (swz % 64) / 2; }
__host__ __device__ __forceinline__ int perm32(int rho) { const int n = rho >> 4, i = rho & 15; return 8 * (i >> 2) + 4 * n + (i & 3); }

struct Unit { int pm, pn, z; const char* a; const char* b; };

struct Sched {
    int nM, nN, nwg, G, c, per_z; const char* A; const char* B; size_t tA, tB, zA, zB;
    __device__ __forceinline__ void init(const void* A_, const void* B_, int nM_, int nN_, int nZ, size_t lda, size_t ldb, size_t zA_el, size_t zB_el, int G_, int c_) {
        A = (const char*)A_; B = (const char*)B_; nM = nM_; nN = nN_; per_z = nM_ * nN_; nwg = per_z * nZ; G = G_; c = c_;
        tA = (size_t)BM * lda * 2; tB = (size_t)BM * ldb * 2; zA = zA_el * 2; zB = zB_el * 2;
    }
    __device__ __forceinline__ bool next(int i, Unit& u) const {
        const long L = (long)i * G + c; if (L >= nwg) return false;
        int wgid = (int)L; { const int q = nwg / NXCD, r = nwg % NXCD, xcd = wgid % NXCD, off = wgid / NXCD; wgid = (xcd < r ? xcd * (q + 1) : r * (q + 1) + (xcd - r) * q) + off; }
        const int z = wgid / per_z, w = wgid % per_z;
        const int nig = WGM * nN, gid = w / nig, fm = gid * WGM, gsz = (nM - fm) < WGM ? (nM - fm) : WGM;
        u.pm = fm + ((w % nig) % gsz); u.pn = (w % nig) / gsz; u.z = z;
        u.a = A + (size_t)z * zA + (size_t)u.pm * tA; u.b = B + (size_t)z * zB + (size_t)u.pn * tB; return true;
    }
};

template <class Epi>
__device__ __forceinline__ void gemm_phase(LAS unsigned char* lds, const int K_, const int lda_, const int ldb_, const Sched& S, const Epi& E) {
    int K = K_, lda = lda_, ldb = ldb_; asm volatile("" : "+s"(K), "+s"(lda), "+s"(ldb));
    int tid = threadIdx.x; asm volatile("" : "+v"(tid));
    const int wid = __builtin_amdgcn_readfirstlane(tid >> 6), lane = tid & 63, wr = wid >> 2, wc = wid & 3, fr = lane & 15, fq = lane >> 4;
    const int nt = K / BK;
    unsigned voffA[2], voffB[2];
#pragma unroll
    for (int i = 0; i < 2; ++i) { int R, C; stage_rc(tid * 16 + i * 8192, R, C); const int Rb = (R & ~31) + perm32(R & 31);
        voffA[i] = (unsigned)(R * lda + C) * 2u; voffB[i] = (unsigned)(Rb * ldb + C) * 2u; }
    const size_t kstep = (size_t)(BK * 2);
    const size_t hstepA = (size_t)HALF * lda * 2, hstepB = (size_t)HALF * ldb * 2;
    const unsigned ldsw = (unsigned)wid * 1024u;
    const int aoff = lds_byte(wr * 64 + fr, fq * 8), boff = lds_byte(wc * 32 + fr, fq * 8);
#define PG8_SA(b, h) (((b) * 2 + (h)) * HTB)
#define PG8_SB(b, h) ((4 + (b) * 2 + (h)) * HTB)
#define PG8_STAGE(bufoff, gbase, voff) do { const char* _g = (const char*)(gbase); asm volatile("" : "+s"(_g)); _Pragma("unroll") for (int _i = 0; _i < 2; ++_i) \
        __builtin_amdgcn_global_load_lds((const unsigned*)(_g + (voff)[_i]), (LAS unsigned*)(lds + (bufoff) + ldsw + _i * 8192), 16, 0, 0); } while (0)
#define PG8_LDA(dst, b, h) do { _Pragma("unroll") for (int m = 0; m < 4; ++m) _Pragma("unroll") for (int k = 0; k < 2; ++k) dst[m][k] = *(const LAS bf16x8*)(lds + PG8_SA(b, h) + aoff + m * 2048 + k * 1024); } while (0)
#define PG8_LDB(dst, b, h) do { _Pragma("unroll") for (int n = 0; n < 2; ++n) _Pragma("unroll") for (int k = 0; k < 2; ++k) dst[n][k] = *(const LAS bf16x8*)(lds + PG8_SB(b, h) + boff + n * 2048 + k * 1024); } while (0)
#define PG8_MMA(ai, bj, At, Bt) do { __builtin_amdgcn_s_setprio(1); _Pragma("unroll") for (int m = 0; m < 4; ++m) _Pragma("unroll") for (int n = 0; n < 2; ++n) _Pragma("unroll") for (int k = 0; k < 2; ++k) \
        acc[ai][bj][m][n] = __builtin_amdgcn_mfma_f32_16x16x32_bf16(Bt[n][k], At[m][k], acc[ai][bj][m][n], 0, 0, 0); __builtin_amdgcn_s_setprio(0); } while (0)
#define PG8_WAIT_V(n) asm volatile("s_waitcnt vmcnt(" #n ")" ::: "memory")
#define PG8_WAIT_L(n) asm volatile("s_waitcnt lgkmcnt(" #n ")" ::: "memory")
#define PG8_BAR __builtin_amdgcn_s_barrier()
#define PG8_SCHED __builtin_amdgcn_sched_barrier(0)
    Unit cur, nxt; int ui = 0;
    if (!S.next(0, cur)) return;
    f32x4 acc[2][2][4][2];
#pragma unroll
    for (int a = 0; a < 2; ++a)
#pragma unroll
        for (int b = 0; b < 2; ++b)
#pragma unroll
            for (int m = 0; m < 4; ++m)
#pragma unroll
                for (int n = 0; n < 2; ++n) acc[a][b][m][n] = (f32x4){0.f, 0.f, 0.f, 0.f};
    bf16x8 At[4][2], B0[2][2], B1[2][2];
    const char* cA = cur.a; const char* cB = cur.b;
    PG8_STAGE(PG8_SB(0, 0), cB, voffB); PG8_STAGE(PG8_SB(0, 1), cB + hstepB, voffB); PG8_STAGE(PG8_SA(0, 0), cA, voffA); PG8_STAGE(PG8_SA(0, 1), cA + hstepA, voffA);
    if (wr == 1) PG8_BAR;
    PG8_WAIT_V(2); PG8_BAR;
    PG8_STAGE(PG8_SB(1, 0), cB + kstep, voffB); PG8_STAGE(PG8_SA(1, 0), cA + kstep, voffA); PG8_STAGE(PG8_SB(1, 1), cB + hstepB + kstep, voffB);
    PG8_WAIT_V(6); PG8_BAR;
    for (;;) {
        const bool has_next = S.next(ui + 1, nxt);
        const char* nA = has_next ? nxt.a : cA; const char* nB = has_next ? nxt.b : cB;
        for (int t = 0; t < nt; t += 2) {
            const bool last = (t == nt - 2);
            const char* a1 = cA + (size_t)(t + 1) * kstep;
            const char* a2 = last ? nA : cA + (size_t)(t + 2) * kstep; const char* b2 = last ? nB : cB + (size_t)(t + 2) * kstep;
            const char* a3 = a2 + kstep; const char* b3 = b2 + kstep;
            PG8_LDB(B0, 0, 0); PG8_LDB(B1, 0, 1); PG8_SCHED; PG8_LDA(At, 0, 0); PG8_STAGE(PG8_SA(1, 1), a1 + hstepA, voffA);
            PG8_WAIT_V(8); PG8_WAIT_L(0); PG8_BAR; PG8_MMA(0, 0, At, B0); PG8_MMA(0, 1, At, B1); PG8_BAR; PG8_SCHED;
            PG8_LDA(At, 0, 1); PG8_STAGE(PG8_SB(0, 0), b2, voffB); PG8_STAGE(PG8_SB(0, 1), b2 + hstepB, voffB); PG8_STAGE(PG8_SA(0, 0), a2, voffA);
            PG8_WAIT_V(8); PG8_WAIT_L(0); PG8_BAR; PG8_MMA(1, 0, At, B0); PG8_MMA(1, 1, At, B1); PG8_BAR; PG8_SCHED;
            PG8_LDB(B0, 1, 0); PG8_LDB(B1, 1, 1); PG8_SCHED; PG8_LDA(At, 1, 0); PG8_STAGE(PG8_SA(0, 1), a2 + hstepA, voffA);
            PG8_WAIT_V(8); PG8_WAIT_L(0); PG8_BAR; PG8_MMA(0, 0, At, B0); PG8_MMA(0, 1, At, B1); PG8_BAR; PG8_SCHED;
            PG8_LDA(At, 1, 1); PG8_STAGE(PG8_SB(1, 0), b3, voffB); PG8_STAGE(PG8_SB(1, 1), b3 + hstepB, voffB); PG8_STAGE(PG8_SA(1, 0), a3, voffA);
            PG8_WAIT_V(8); PG8_WAIT_L(0); PG8_BAR; PG8_MMA(1, 0, At, B0); PG8_MMA(1, 1, At, B1); PG8_BAR; PG8_SCHED;
        }
        if (wr == 0) PG8_BAR;
        { int fr2 = fr, fq2 = fq; asm volatile("" : "+v"(fr2), "+v"(fq2)); E(acc, cur, wr, wc, fr2, fq2); }
        if (!has_next) break;
#pragma unroll
        for (int a = 0; a < 2; ++a)
#pragma unroll
            for (int b = 0; b < 2; ++b)
#pragma unroll
                for (int m = 0; m < 4; ++m)
#pragma unroll
                    for (int n = 0; n < 2; ++n) acc[a][b][m][n] = (f32x4){0.f, 0.f, 0.f, 0.f};
        cur = nxt; cA = nA; cB = nB; ++ui;
        if (wr == 1) PG8_BAR;
    }
    PG8_WAIT_V(0);
    PG8_BAR;
#undef PG8_SA
#undef PG8_SB
#undef PG8_STAGE
#undef PG8_LDA
#undef PG8_LDB
#undef PG8_MMA
#undef PG8_WAIT_V
#undef PG8_WAIT_L
#undef PG8_BAR
#undef PG8_SCHED
}
}
using pg8::Unit;
typedef f32x4 AccT[2][2][4][2];

#define EPI_ROWS_BEGIN _Pragma("unroll") for (int ai = 0; ai < 2; ++ai) _Pragma("unroll") for (int m = 0; m < 4; ++m) { const int row = u.pm * 256 + ai * 128 + wr * 64 + m * 16 + fr;
#define EPI_ROWS_END asm volatile("" ::: "memory"); }
#define ACC8(dst, ai, bj, m) { const f32x4 _a = acc[ai][bj][m][0], _b = acc[ai][bj][m][1]; dst[0] = _a[0]; dst[1] = _a[1]; dst[2] = _a[2]; dst[3] = _a[3]; dst[4] = _b[0]; dst[5] = _b[1]; dst[6] = _b[2]; dst[7] = _b[3]; }

template <int MODE  > struct EpiPair {
    bf16_t* O; int ldo;
    __device__ __forceinline__ void operator()(const AccT& acc, const Unit& u, int wr, int wc, int fr, int fq) const {
        const int col = u.pn * 128 + wc * 32 + 8 * fq;
        EPI_ROWS_BEGIN
            float a[8], b[8], r[8]; ACC8(a, ai, 0, m); ACC8(b, ai, 1, m);
#pragma unroll
            for (int j = 0; j < 8; ++j) r[j] = MODE == 0 ? siluf_(a[j]) * b[j] : a[j] * sigmoidf_(b[j]);
            *(u32x4*)(O + (size_t)row * ldo + col) = pack8(r);
        EPI_ROWS_END
    }
};
struct EpiRes {
    float* H; const float* gate; float sc;
    __device__ __forceinline__ void operator()(const AccT& acc, const Unit& u, int wr, int wc, int fr, int fq) const {
        EPI_ROWS_BEGIN
            const int bi = row < ML ? (row >> 12) : 8;
#pragma unroll
            for (int bj = 0; bj < 2; ++bj) {
                const int col = u.pn * 256 + bj * 128 + wc * 32 + 8 * fq;
                float* p = H + (size_t)row * DM + col; const float* gp = gate + bi * NMOD + col;
                f32x4 h0 = *(const f32x4*)p, h1 = *(const f32x4*)(p + 4); const f32x4 g0 = *(const f32x4*)gp, g1 = *(const f32x4*)(gp + 4);
                h0 += (g0 * sc) * acc[ai][bj][m][0]; h1 += (g1 * sc) * acc[ai][bj][m][1];
                *(f32x4*)p = h0; *(f32x4*)(p + 4) = h1;
            }
        EPI_ROWS_END
    }
};
struct EpiInT {
    bf16_t* VT2; bf16_t* VT2C;
    __device__ __forceinline__ void operator()(const AccT& acc, const Unit& u, int wr, int wc, int fr, int fq) const {
        EPI_ROWS_BEGIN
            const int grp = row >> 8, part = (row >> 7) & 1, ch = grp * 128 + (row & 127);
#pragma unroll
            for (int bj = 0; bj < 2; ++bj) {
                const int m0 = u.pn * 256 + bj * 128 + wc * 32 + 8 * fq;
                float r[8]; ACC8(r, ai, bj, m);
                bf16_t* dst;
                if (m0 < ML) { const int b = m0 >> 12, t = m0 & 4095; dst = VT2 + ((size_t)(b * 512 + ch) * 8192 + part * 4096 + t); }
                else { const int mm = m0 - ML, b = mm >> 8, t = mm & 255; dst = VT2C + ((size_t)(b * 512 + ch) * 512 + part * 256 + t); }
                *(u32x4*)dst = pack8(r);
            }
        EPI_ROWS_END
    }
};
struct EpiInU {
    bf16_t* UG;
    __device__ __forceinline__ void operator()(const AccT& acc, const Unit& u, int wr, int wc, int fr, int fq) const {
        EPI_ROWS_BEGIN
            int urow, ii;
            if (row < ML) { const int b = row >> 12, t = row & 4095; urow = b * 256 + (t >> 4); ii = t & 15; }
            else { const int mm = row - ML, b = mm >> 8, t = mm & 255; urow = 2048 + b * 16 + (t >> 4); ii = t & 15; }
#pragma unroll
            for (int bj = 0; bj < 2; ++bj) {
                float r[8]; ACC8(r, ai, bj, m);
                const int c = u.pn * 256 + bj * 128 + wc * 32 + 8 * fq, g = c >> 4, h0 = c & 15;
                *(u32x4*)(UG + ((size_t)(g * UROWS + urow) * 256 + ii * 16 + h0)) = pack8(r);
            }
        EPI_ROWS_END
    }
};
struct EpiInG {
    bf16_t* SGF; bf16_t* SGS;
    __device__ __forceinline__ void operator()(const AccT& acc, const Unit& u, int wr, int wc, int fr, int fq) const {
        bf16_t* base = u.pn < 4 ? SGF : SGS; const int c0 = (u.pn & 3) * 256 + wc * 32 + 8 * fq;
        EPI_ROWS_BEGIN
#pragma unroll
            for (int bj = 0; bj < 2; ++bj) {
                float r[8]; ACC8(r, ai, bj, m);
#pragma unroll
                for (int j = 0; j < 8; ++j) r[j] = sigmoidf_(r[j]);
                *(u32x4*)(base + (size_t)row * DM + c0 + bj * 128) = pack8(r);
            }
        EPI_ROWS_END
    }
};
struct EpiF2 {
    bf16_t* O; int rbase, zrows, ldo;
    __device__ __forceinline__ void operator()(const AccT& acc, const Unit& u, int wr, int wc, int fr, int fq) const {
        EPI_ROWS_BEGIN
            const size_t orow = (size_t)(rbase + u.z * zrows + row);
#pragma unroll
            for (int bj = 0; bj < 2; ++bj) { float r[8]; ACC8(r, ai, bj, m); *(u32x4*)(O + orow * ldo + u.pn * 256 + bj * 128 + wc * 32 + 8 * fq) = pack8(r); }
        EPI_ROWS_END
    }
};
struct EpiSsmA {
    bf16_t* YI; float* S;
    __device__ __forceinline__ void operator()(const AccT& acc, const Unit& u, int wr, int wc, int fr, int fq) const {
        EPI_ROWS_BEGIN
            const size_t base = ((size_t)u.z * UROWS + row) * 256;
#pragma unroll
            for (int bj = 0; bj < 2; ++bj) {
                const int col = bj * 128 + wc * 32 + 8 * fq;
                if (u.pn == 0) { float r[8]; ACC8(r, ai, bj, m); *(u32x4*)(YI + base + col) = pack8(r); }
                else { *(f32x4*)(S + base + col) = acc[ai][bj][m][0]; *(f32x4*)(S + base + col + 4) = acc[ai][bj][m][1]; }
            }
        EPI_ROWS_END
    }
};
struct EpiSsmB {
    const bf16_t* YI; bf16_t* YS;
    __device__ __forceinline__ void operator()(const AccT& acc, const Unit& u, int wr, int wc, int fr, int fq) const {
        EPI_ROWS_BEGIN
            int tok0;
            if (row < 2048) tok0 = (row >> 8) * 4096 + (row & 255) * 16;
            else { const int rr = row - 2048; tok0 = ML + (rr >> 4) * 256 + (rr & 15) * 16; }
            if (row < 2176) {
                const size_t base = ((size_t)u.z * UROWS + row) * 256;
#pragma unroll
                for (int bj = 0; bj < 2; ++bj) {
                    const int col = bj * 128 + wc * 32 + 8 * fq, j = col >> 4, h0 = col & 15;
                    float r[8], yi[8]; ACC8(r, ai, bj, m); unpack8(*(const u32x4*)(YI + base + col), yi);
#pragma unroll
                    for (int q = 0; q < 8; ++q) r[q] = gelu_tanh(r[q] + yi[q]);
                    *(u32x4*)(YS + (size_t)(tok0 + j) * 512 + u.z * 16 + h0) = pack8(r);
                }
            }
        EPI_ROWS_END
    }
};
struct EpiFo {
    bf16_t* SGF;
    __device__ __forceinline__ void operator()(const AccT& acc, const Unit& u, int wr, int wc, int fr, int fq) const {
        EPI_ROWS_BEGIN
#pragma unroll
            for (int bj = 0; bj < 2; ++bj) {
                bf16_t* p = SGF + (size_t)row * DM + u.pn * 256 + bj * 128 + wc * 32 + 8 * fq;
                float r[8], g[8]; ACC8(r, ai, bj, m); unpack8(*(const u32x4*)p, g);
#pragma unroll
                for (int q = 0; q < 8; ++q) r[q] *= g[q];
                *(u32x4*)p = pack8(r);
            }
        EPI_ROWS_END
    }
};
struct EpiSso {
    bf16_t* SGS; const bf16_t* MG1;
    __device__ __forceinline__ void operator()(const AccT& acc, const Unit& u, int wr, int wc, int fr, int fq) const {
        EPI_ROWS_BEGIN
#pragma unroll
            for (int bj = 0; bj < 2; ++bj) {
                const size_t off = (size_t)row * DM + u.pn * 256 + bj * 128 + wc * 32 + 8 * fq;
                float r[8], g[8], f[8]; ACC8(r, ai, bj, m); unpack8(*(const u32x4*)(SGS + off), g); unpack8(*(const u32x4*)(MG1 + off), f);
#pragma unroll
                for (int q = 0; q < 8; ++q) r[q] = f[q] + g[q] * r[q];
                *(u32x4*)(SGS + off) = pack8(r);
            }
        EPI_ROWS_END
    }
};

struct Ctx { LAS unsigned char* lds; int tid, lane, wave, G, bid, gw, NGW; };
#define CTX_REFRESH(C) do { int _t = threadIdx.x; asm volatile("" : "+v"(_t)); (C).tid = _t; (C).lane = _t & 63; } while (0)

__device__ __forceinline__ void transpose_item(const Ctx& C, const float* W, int K, int ldw, int n0, int ncols, bf16_t* WT, int mode, int half, int row_off, int item) {
    LAS float* scr = (LAS float*)(C.lds + C.wave * 16384);
    const int nblk = ncols / 32, kb = item / nblk, nb = item % nblk, k0 = 64 * kb, nr0 = 32 * nb, lane = C.lane;
    int r0;
    if (mode == 0) r0 = row_off + nr0;
    else { const int hsel = nr0 >= half ? 1 : 0, j = nr0 - hsel * half; r0 = (j >> 7) * 256 + hsel * 128 + (j & 127); }
#pragma unroll 8
    for (int i = 0; i < 32; ++i) { const int kk = 2 * i + (lane >> 5); scr[kk * 33 + (lane & 31)] = W[(size_t)(k0 + kk) * ldw + n0 + nr0 + (lane & 31)]; }
    asm volatile("s_waitcnt lgkmcnt(0)" ::: "memory");
    const int c = lane & 7;
#pragma unroll
    for (int j = 0; j < 4; ++j) { const int n = (lane >> 3) + 8 * j; const LAS float* s = scr + (8 * c) * 33 + n;
        u32x4 o; o.x = cvt_pk_bf16(s[0 * 33], s[1 * 33]); o.y = cvt_pk_bf16(s[2 * 33], s[3 * 33]); o.z = cvt_pk_bf16(s[4 * 33], s[5 * 33]); o.w = cvt_pk_bf16(s[6 * 33], s[7 * 33]);
        *(u32x4*)(WT + (size_t)(r0 + n) * K + k0 + 8 * c) = o; }
    asm volatile("s_waitcnt lgkmcnt(0)" ::: "memory");
}
__device__ __forceinline__ void transpose_mat(const Ctx& C, const float* W, int K, int ldw, int n0, int ncols, bf16_t* WT, int mode, int half, int row_off) {
    const int items = (K / 64) * (ncols / 32);
    for (int it = C.gw; it < items; it += C.NGW) transpose_item(C, W, K, ldw, n0, ncols, WT, mode, half, row_off, it);
}

__device__ __forceinline__ void fourier_weight_phase(const Ctx& C, const float* Win  , bf16_t* WT) {
    LAS float* Wl = (LAS float*)C.lds; LAS float* ct = Wl + 64 * 129; LAS float* st = ct + 128;
    for (int it = C.bid; it < 64; it += C.G) {
        const int grp = it >> 4, k0 = (it & 15) * 64;
        for (int e = C.tid; e < 64 * 128; e += 512) { const int k = e >> 7, c = e & 127; Wl[k * 129 + c] = Win[(size_t)(k0 + k) * 3072 + grp * 128 + c]; }
        if (C.tid < 128) { float s, c; sincosf(6.283185307179586f * (float)C.tid * (1.f / 128.f), &s, &c); ct[C.tid] = c; st[C.tid] = s; }
        __syncthreads();
        const int k = C.tid & 63, jj = C.tid >> 6;
        for (int i = 0; i < 32; ++i) {
            const int n2 = jj * 32 + i, part = n2 >> 7, j = n2 & 127; const LAS float* tb = part ? st : ct;
            float a = 0.f;
#pragma unroll 8
            for (int c = 0; c < 128; ++c) a += Wl[k * 129 + c] * tb[(c * j) & 127];
            const unsigned pk = cvt_pk_bf16(a * 0.08838834764831845f, 0.f);
            WT[(size_t)(grp * 256 + n2) * 1024 + k0 + k] = (bf16_t)(pk & 0xffffu);
        }
        __syncthreads();
    }
}

struct SsmP { const float *lre, *lim, *lst, *bre, *bim, *cre, *cim, *dd; };
__device__ __forceinline__ void ssm_mats_phase(const Ctx& C, const SsmP& P, bf16_t* Wa, bf16_t* Wb) {
    LAS float* LP = (LAS float*)C.lds;
    LAS float* BB = LP + 2 * 17 * 64 * 2;
    LAS float* CC = BB + 2 * 64 * 16 * 2;
    LAS float* KK = CC + 2 * 16 * 64 * 2;
    const int tid = C.tid;
    for (int g = C.bid; g < 32; g += C.G) {
        if (tid < 128) {
            const int d = tid >> 6, p = tid & 63;
            const float dt = expf(P.lst[d * 32 + g]); const float lr = P.lre[(d * 32 + g) * 64 + p], li = P.lim[(d * 32 + g) * 64 + p];
            float l1r = 0.f, l1i = 0.f;
            for (int t = 0; t <= 16; ++t) { const float mag = expf(lr * dt * (float)t); float s, c; sincosf(li * dt * (float)t, &s, &c);
                LP[((d * 17 + t) * 64 + p) * 2] = mag * c; LP[((d * 17 + t) * 64 + p) * 2 + 1] = mag * s; if (t == 1) { l1r = mag * c; l1i = mag * s; } }
            const float nr = l1r - 1.f, ni = l1i, den = lr * lr + li * li;
            const float kr = (nr * lr + ni * li) / den, ki = (ni * lr - nr * li) / den;
            for (int h = 0; h < 16; ++h) { const size_t bi_ = ((size_t)(d * 32 + g) * 64 + p) * 16 + h; const float br = P.bre[bi_], bi = P.bim[bi_];
                BB[((d * 64 + p) * 16 + h) * 2] = kr * br - ki * bi; BB[((d * 64 + p) * 16 + h) * 2 + 1] = kr * bi + ki * br; }
        }
        for (int e = tid; e < 2048; e += 512) { const int d = e >> 10, h = (e >> 6) & 15, p = e & 63; const size_t ci_ = ((size_t)(d * 32 + g) * 16 + h) * 64 + p;
            CC[e * 2] = P.cre[ci_]; CC[e * 2 + 1] = P.cim[ci_]; }
        __syncthreads();
        for (int o = tid; o < 8192; o += 512) {
            const int d = o >> 12, t = (o >> 8) & 15, h = (o >> 4) & 15, hp = o & 15;
            float a = 0.f;
            for (int p = 0; p < 64; ++p) {
                const float cr = CC[((d * 16 + h) * 64 + p) * 2], ci = CC[((d * 16 + h) * 64 + p) * 2 + 1];
                const float Lr = LP[((d * 17 + t) * 64 + p) * 2], Li = LP[((d * 17 + t) * 64 + p) * 2 + 1];
                const float br = BB[((d * 64 + p) * 16 + hp) * 2], bi = BB[((d * 64 + p) * 16 + hp) * 2 + 1];
                const float er = Lr * br - Li * bi, ei = Lr * bi + Li * br;
                a += cr * er - ci * ei;
            }
            KK[o] = a;
        }
        __syncthreads();
        bf16_t* wa = Wa + (size_t)g * 512 * 256;
        for (int v = tid; v < 512 * 32; v += 512) {
            const int n = v >> 5, kv = (v & 31) * 8, i = kv >> 4, hp0 = kv & 15;
            float r[8];
            if (n < 256) {
                const int j = n >> 4, h = n & 15;
#pragma unroll
                for (int q = 0; q < 8; ++q) { const int hp = hp0 + q; float x = 0.f;
                    if (j >= i) x += KK[((0 * 16 + (j - i)) * 16 + h) * 16 + hp];
                    if (i >= j) x += KK[((1 * 16 + (i - j)) * 16 + h) * 16 + hp];
                    if (i == j && h == hp) x += P.dd[g * 16 + h];
                    r[q] = x; }
            } else {
                const int qn = n - 256, d = qn >> 7, ri = (qn >> 6) & 1, p = qn & 63, t = d == 0 ? 15 - i : i;
                const float Lr = LP[((d * 17 + t) * 64 + p) * 2], Li = LP[((d * 17 + t) * 64 + p) * 2 + 1];
#pragma unroll
                for (int q = 0; q < 8; ++q) { const int hp = hp0 + q; const float br = BB[((d * 64 + p) * 16 + hp) * 2], bi = BB[((d * 64 + p) * 16 + hp) * 2 + 1];
                    r[q] = ri ? (Lr * bi + Li * br) : (Lr * br - Li * bi); }
            }
            *(u32x4*)(wa + (size_t)n * 256 + kv) = pack8(r);
        }
        bf16_t* wb = Wb + (size_t)g * 256 * 256;
        for (int v = tid; v < 256 * 32; v += 512) {
            const int n = v >> 5, kv = (v & 31) * 8, j = n >> 4, h = n & 15, d = kv >> 7, ri = (kv >> 6) & 1, p0 = kv & 63, e = d == 0 ? j + 1 : 16 - j;
            float r[8];
#pragma unroll
            for (int q = 0; q < 8; ++q) { const int p = p0 + q;
                const float cr = CC[((d * 16 + h) * 64 + p) * 2], ci = CC[((d * 16 + h) * 64 + p) * 2 + 1];
                const float Lr = LP[((d * 17 + e) * 64 + p) * 2], Li = LP[((d * 17 + e) * 64 + p) * 2 + 1];
                r[q] = ri ? -(cr * Li + ci * Lr) : (cr * Lr - ci * Li); }
            *(u32x4*)(wb + (size_t)n * 256 + kv) = pack8(r);
        }
        __syncthreads();
    }
}

__device__ __forceinline__ void ssm_scan_phase(const Ctx& C, const SsmP& P, const float* S, bf16_t* Hin) {
    for (int it = C.bid; it < 256; it += C.G) {
        const int g = it >> 3, b = it & 7;
        if (C.tid < 128) {
            const int d = C.tid >> 6, p = C.tid & 63;
            const float dt = expf(P.lst[d * 32 + g]); const float lr = P.lre[(d * 32 + g) * 64 + p], li = P.lim[(d * 32 + g) * 64 + p];
            const float mag = expf(lr * dt * 16.f); float sn, cs; sincosf(li * dt * 16.f, &sn, &cs);
            const float Ar = mag * cs, Ai = mag * sn;
            float hr = 0.f, hi = 0.f;
            const float* Sg = S + (size_t)g * UROWS * 256 + d * 128 + p; bf16_t* Hg = Hin + (size_t)g * UROWS * 256 + d * 128 + p;
            for (int s0 = 0; s0 < 272; s0 += 16) {
                float sr[16], si[16];
                int rowb, dir;
                if (s0 == 0) { rowb = 2048 + b * 16 + (d ? 15 : 0); dir = d ? -1 : 1; }
                else { rowb = b * 256 + (d ? 271 - s0 : s0 - 16); dir = d ? -1 : 1; }
#pragma unroll
                for (int q = 0; q < 16; ++q) { const size_t o = (size_t)(rowb + dir * q) * 256; sr[q] = Sg[o]; si[q] = Sg[o + 64]; }
#pragma unroll
                for (int q = 0; q < 16; ++q) { const size_t o = (size_t)(rowb + dir * q) * 256;
                    const unsigned pk = cvt_pk_bf16(hr, hi); Hg[o] = (bf16_t)(pk & 0xffffu); Hg[o + 64] = (bf16_t)(pk >> 16);
                    const float nr = Ar * hr - Ai * hi + sr[q], ni = Ar * hi + Ai * hr + si[q]; hr = nr; hi = ni; }
            }
        }
    }
}

__device__ __forceinline__ void mod_partial_phase(const Ctx& C, const float* cvec, const float* cctx, const float* wmod, float* MODP) {
    LAS float* cvs = (LAS float*)C.lds;
    for (int it = C.bid; it < 4 * 18 * 16; it += C.G) {
        const int l = it / 288, rem = it % 288, nb = rem >> 4, kc = rem & 15;
        __syncthreads();
        for (int e = C.tid; e < 576; e += 512) { const int r = e >> 6, k = e & 63; const float v = r < 8 ? cvec[r * 1024 + kc * 64 + k] : cctx[kc * 64 + k]; cvs[e] = v / (1.f + expf(-v)); }
        __syncthreads();
        const int n = nb * 512 + C.tid;
        float a[9];
#pragma unroll
        for (int r = 0; r < 9; ++r) a[r] = 0.f;
        const float* wp = wmod + ((size_t)l * 1024 + kc * 64) * NMOD + n;
#pragma unroll 8
        for (int k = 0; k < 64; ++k) { const float w = wp[(size_t)k * NMOD];
#pragma unroll
            for (int r = 0; r < 9; ++r) a[r] += cvs[r * 64 + k] * w; }
#pragma unroll
        for (int r = 0; r < 9; ++r) MODP[((size_t)(kc * 4 + l) * 9 + r) * NMOD + n] = a[r];
    }
}
__device__ __forceinline__ void mod_final_phase(const Ctx& C, const float* bmod, const float* MODP, float* MOD) {
    for (int e = C.bid * 512 + C.tid; e < 4 * 9 * NMOD; e += C.G * 512) {
        const int l = e / (9 * NMOD), n = e % NMOD; float a = bmod[l * NMOD + n];
#pragma unroll
        for (int kc = 0; kc < 16; ++kc) a += MODP[(size_t)kc * (4 * 9 * NMOD) + e];
        MOD[e] = a;
    }
}
__device__ __forceinline__ void dft_gen_phase(const Ctx& C, bf16_t* DFT, bf16_t* DFTC) {
    LAS float* tab = (LAS float*)C.lds;
    __syncthreads();
    for (int i = C.tid; i < 4096; i += 512) tab[i] = cosf(6.283185307179586f * (float)i * (1.f / 4096.f));
    __syncthreads();
    const size_t nv = (size_t)4096 * 8192 / 8;
    for (size_t v = (size_t)C.bid * 512 + C.tid; v < nv; v += (size_t)C.G * 512) {
        const int k = (int)(v >> 10), kk0 = (int)(v & 1023) * 8, part = kk0 >> 12, t0 = kk0 & 4095;
        float r[8];
#pragma unroll
        for (int q = 0; q < 8; ++q) { const int idx = (k * (t0 + q)) & 4095; r[q] = (part ? -tab[(idx - 1024) & 4095] : tab[idx]) * (1.f / 64.f); }
        *(u32x4*)(DFT + v * 8) = pack8(r);
    }
    for (int v = C.bid * 512 + C.tid; v < 256 * 512 / 8; v += C.G * 512) {
        const int k = v >> 6, kk0 = (v & 63) * 8, part = kk0 >> 8, t0 = kk0 & 255;
        float r[8];
#pragma unroll
        for (int q = 0; q < 8; ++q) { const int idx = ((k * (t0 + q)) & 255) * 16; r[q] = (part ? -tab[(idx - 1024) & 4095] : tab[idx]) * (1.f / 16.f); }
        *(u32x4*)(DFTC + (size_t)v * 8) = pack8(r);
    }
}
__device__ __forceinline__ void norm_phase(const Ctx& C, const float* H, const float* MODl, const float* gvec, int kmod, bf16_t* AN) {
    for (int m = C.gw; m < MT; m += C.NGW) {
        const int bi = m < ML ? (m >> 12) : 8;
        const float* shift = MODl + bi * NMOD + kmod * 1024; const float* scale = shift + 1024;
        const f32x4* xr = (const f32x4*)(H + (size_t)m * DM) + C.lane;
        f32x4 v[4]; float s = 0.f;
#pragma unroll
        for (int j = 0; j < 4; ++j) { v[j] = xr[64 * j]; s += (v[j][0] * v[j][0] + v[j][1] * v[j][1]) + (v[j][2] * v[j][2] + v[j][3] * v[j][3]); }
        const float r = rsqrtf(wave_sum(s) * (1.f / 1024.f) + 1e-6f);
#pragma unroll
        for (int j = 0; j < 4; ++j) { const int c = 4 * (C.lane + 64 * j);
            const f32x4 g4 = *(const f32x4*)(gvec + c), sc4 = *(const f32x4*)(scale + c), sh4 = *(const f32x4*)(shift + c);
            const f32x4 y = (v[j] * r * g4) * (sc4 + 1.f) + sh4;
            u32x2 w; w.x = cvt_pk_bf16(y[0], y[1]); w.y = cvt_pk_bf16(y[2], y[3]);
            *(u32x2*)(AN + (size_t)m * DM + c) = w; }
    }
}
__device__ __forceinline__ void final_norm_phase(const Ctx& C, const float* H, const float* gvec, float* out) {
    for (int m = C.gw; m < ML; m += C.NGW) {
        const f32x4* xr = (const f32x4*)(H + (size_t)m * DM) + C.lane;
        f32x4 v[4]; float s = 0.f;
#pragma unroll
        for (int j = 0; j < 4; ++j) { v[j] = xr[64 * j]; s += (v[j][0] * v[j][0] + v[j][1] * v[j][1]) + (v[j][2] * v[j][2] + v[j][3] * v[j][3]); }
        const float r = rsqrtf(wave_sum(s) * (1.f / 1024.f) + 1e-6f);
#pragma unroll
        for (int j = 0; j < 4; ++j) { const int c = 4 * (C.lane + 64 * j); const f32x4 g4 = *(const f32x4*)(gvec + c);
            *(f32x4*)(out + (size_t)m * DM + c) = v[j] * r * g4; }
    }
}

__device__ __forceinline__ void dump_phase(const Ctx& C, const bf16_t* a, const bf16_t* b, float* out) {
    const size_t n = (size_t)ML * 512;
    for (size_t i = (size_t)C.bid * 512 + C.tid; i < n; i += (size_t)C.G * 512) { out[i] = __uint_as_float((unsigned)a[i] << 16); out[n + i] = __uint_as_float((unsigned)b[i] << 16); }
}
#define GRID_SYNC() do { asm volatile("s_waitcnt vmcnt(0) lgkmcnt(0)" ::: "memory"); grid.sync(); __builtin_amdgcn_fence(__ATOMIC_ACQUIRE, "agent"); asm volatile("s_waitcnt vmcnt(0)" ::: "memory"); } while (0)
struct Args { const float* in[25]; float* out; unsigned char* ws; };

__global__ void __launch_bounds__(512, 2) fwd_mega(Args args) {
    extern __shared__ __attribute__((aligned(16))) unsigned char lds_raw[];
    cg::grid_group grid = cg::this_grid();
    Ctx C; C.lds = (LAS unsigned char*)lds_raw; C.tid = threadIdx.x; C.lane = C.tid & 63; C.wave = __builtin_amdgcn_readfirstlane(C.tid >> 6);
    C.G = gridDim.x; C.bid = blockIdx.x; C.gw = C.bid * 8 + C.wave; C.NGW = C.G * 8;
    unsigned char* ws = args.ws;
    const float *x = args.in[0], *cvec = args.in[1], *ctxin = args.in[2], *cctx = args.in[3], *wmod = args.in[4], *bmod = args.in[5], *normg = args.in[6];
    const float *f1w13 = args.in[7], *f1w2 = args.in[8], *win = args.in[9], *wfo = args.in[10];
    const float *lre = args.in[11], *lim = args.in[12], *lst = args.in[13], *bre = args.in[14], *bim = args.in[15], *cre = args.in[16], *cim = args.in[17], *sd = args.in[18];
    const float *wglu = args.in[19], *wsso = args.in[20], *wout = args.in[21], *f2w13 = args.in[22], *f2w2 = args.in[23], *fing = args.in[24];
    float* H = (float*)(ws + WS_H); float* MOD = (float*)(ws + WS_MOD); float* MODP = (float*)(ws + X_MODP);
    bf16_t* HID = (bf16_t*)(ws + X_HID); bf16_t* AN_FFN = (bf16_t*)(ws + X_AN_FFN); bf16_t* AN_MIX = (bf16_t*)(ws + X_AN_MIX);
    bf16_t* VT2 = (bf16_t*)(ws + X_VT2); bf16_t* VT2C = (bf16_t*)(ws + X_VT2C); bf16_t* SGF = (bf16_t*)(ws + X_SGF); bf16_t* SGS = (bf16_t*)(ws + X_SGS);
    bf16_t* UG = (bf16_t*)(ws + X_UG); bf16_t* HIN = UG; float* SB = (float*)(ws + X_S); bf16_t* YS = (bf16_t*)(ws + X_YS); bf16_t* ZG = (bf16_t*)(ws + X_ZG);
    bf16_t* YF = (bf16_t*)(ws + X_YF); bf16_t* YI = (bf16_t*)(ws + X_YI);
    bf16_t* DFT = (bf16_t*)(ws + WS_DFT); bf16_t* DFTC = (bf16_t*)(ws + WS_DFTC);
    bf16_t* W13 = (bf16_t*)(ws + W_13); bf16_t* W2 = (bf16_t*)(ws + W_2); bf16_t* WIN = (bf16_t*)(ws + W_IN); bf16_t* WFO = (bf16_t*)(ws + W_FO);
    bf16_t* WGLU = (bf16_t*)(ws + W_GLU); bf16_t* WSSO = (bf16_t*)(ws + W_SSO); bf16_t* WOUT = (bf16_t*)(ws + W_OUT); bf16_t* WSA = (bf16_t*)(ws + W_SA); bf16_t* WSB = (bf16_t*)(ws + W_SB);
    const int G = C.G, bid = C.bid;

    {
        const size_t nl = (size_t)ML * DM / 4, nc = (size_t)MC * DM / 4;
        for (size_t i = (size_t)bid * 512 + C.tid; i < nl + nc; i += (size_t)G * 512) ((f32x4*)H)[i] = i < nl ? ((const f32x4*)x)[i] : ((const f32x4*)ctxin)[i - nl];
        mod_partial_phase(C, cvec, cctx, wmod, MODP);
        dft_gen_phase(C, DFT, DFTC);
    }
    GRID_SYNC();
    mod_final_phase(C, bmod, MODP, MOD);

    for (int l = 0; l < DEPTH; ++l) {
        const float* MODl = MOD + (size_t)l * 9 * NMOD;
        SsmP P; P.lre = lre + l * 4096; P.lim = lim + l * 4096; P.lst = lst + l * 64; P.bre = bre + (size_t)l * 65536; P.bim = bim + (size_t)l * 65536;
        P.cre = cre + (size_t)l * 65536; P.cim = cim + (size_t)l * 65536; P.dd = sd + l * 512;
#ifndef NO_PREP
        CTX_REFRESH(C);
        __syncthreads();
        transpose_mat(C, f1w13 + (size_t)l * 1024 * 5632, 1024, 5632, 0, 5632, W13, 1, 2816, 0);
        transpose_mat(C, f1w2 + (size_t)l * 2816 * 1024, 2816, 1024, 0, 1024, W2, 0, 0, 0);
        transpose_mat(C, win + (size_t)l * 1024 * 3072, 1024, 3072, 512, 2560, WIN, 0, 0, 1024);
        transpose_mat(C, wfo + (size_t)l * 512 * 1024, 512, 1024, 0, 1024, WFO, 0, 0, 0);
        transpose_mat(C, wglu + (size_t)l * 512 * 1024, 512, 1024, 0, 1024, WGLU, 1, 512, 0);
        transpose_mat(C, wsso + (size_t)l * 512 * 1024, 512, 1024, 0, 1024, WSSO, 0, 0, 0);
        transpose_mat(C, wout + (size_t)l * 1024 * 1024, 1024, 1024, 0, 1024, WOUT, 0, 0, 0);
        __syncthreads();
        CTX_REFRESH(C);
        fourier_weight_phase(C, win + (size_t)l * 1024 * 3072, WIN);
        CTX_REFRESH(C);
        ssm_mats_phase(C, P, WSA, WSB);
#endif
        GRID_SYNC(); CTX_REFRESH(C);

        for (int f = 0; f < 2; ++f) {
#ifndef NO_MIX
            if (f == 1) {
                norm_phase(C, H, MODl, normg + (l * 3 + 1) * 1024, 3, AN_MIX);
                CTX_REFRESH(C);
                __syncthreads();
                transpose_mat(C, f2w13 + (size_t)l * 1024 * 5632, 1024, 5632, 0, 5632, W13, 1, 2816, 0);
                transpose_mat(C, f2w2 + (size_t)l * 2816 * 1024, 2816, 1024, 0, 1024, W2, 0, 0, 0);
                __syncthreads();
                GRID_SYNC(); CTX_REFRESH(C);
#if defined(DUMP) && DUMP == 8
                {
                    pg8::Sched S; S.init(AN_MIX, W13, MT / 256, 22, 1, 1024, 1024, 0, 0, G, bid);
                    EpiPair<0> E{HID, DFF}; pg8::gemm_phase(C.lds, 1024, 1024, 1024, S, E);
                }
                GRID_SYNC(); CTX_REFRESH(C);
                dump_phase(C, HID, HID + (size_t)ML * 512, args.out); return;
#endif
#if defined(DUMP) && DUMP == 5
                dump_phase(C, AN_MIX, AN_MIX + (size_t)ML * 512, args.out); return;
#endif
#if defined(DUMP) && DUMP == 6
                { const size_t nw = (size_t)24 * MiB / 2, nall = (size_t)ML * DM;
                  for (size_t i = (size_t)C.bid * 512 + C.tid; i < nall; i += (size_t)C.G * 512) args.out[i] = i < nw ? __uint_as_float((unsigned)WIN[i] << 16) : 0.f; }
                return;
#endif
#if (MIXSEL >> 0) & 1
                {
                    pg8::Sched S; S.init(WIN, AN_MIX, 4, MT / 256, 1, 1024, 1024, 0, 0, G, bid);
                    EpiInT E{VT2, VT2C}; pg8::gemm_phase(C.lds, 1024, 1024, 1024, S, E);
                }
#endif
#if (MIXSEL >> 1) & 1
                {
                    pg8::Sched S; S.init(AN_MIX, WIN + (size_t)1024 * 1024, MT / 256, 2, 1, 1024, 1024, 0, 0, G, bid);
                    EpiInU E{UG}; pg8::gemm_phase(C.lds, 1024, 1024, 1024, S, E);
                }
                {
                    pg8::Sched S; S.init(AN_MIX, WIN + (size_t)1536 * 1024, MT / 256, 8, 1, 1024, 1024, 0, 0, G, bid);
                    EpiInG E{SGF, SGS}; pg8::gemm_phase(C.lds, 1024, 1024, 1024, S, E);
                }
#endif
                GRID_SYNC(); CTX_REFRESH(C);
#if defined(DUMP) && DUMP == 3
                dump_phase(C, SGF, SGS, args.out); return;
#endif
#if defined(DUMP) && DUMP == 4
                dump_phase(C, VT2, VT2 + (size_t)ML * 512, args.out); return;
#endif
#if (MIXSEL >> 2) & 1
                {
                    pg8::Sched S; S.init(DFT, VT2, 16, 2, 8, 8192, 8192, 0, (size_t)512 * 8192, G, bid);
                    EpiF2 E{YF, 0, 4096, 512}; pg8::gemm_phase(C.lds, 8192, 8192, 8192, S, E);
                }
#endif
#if (MIXSEL >> 3) & 1
                {
                    pg8::Sched S; S.init(DFTC, VT2C, 1, 2, 8, 512, 512, 0, (size_t)512 * 512, G, bid);
                    EpiF2 E{YF, ML, 256, 512}; pg8::gemm_phase(C.lds, 512, 512, 512, S, E);
                }
#endif
                GRID_SYNC(); CTX_REFRESH(C);
#if defined(DUMP) && DUMP == 1
                dump_phase(C, YF, SGS, args.out); return;
#endif
#if (MIXSEL >> 4) & 1
                {
                    pg8::Sched S; S.init(UG, WSA, 9, 2, 32, 256, 256, (size_t)UROWS * 256, (size_t)512 * 256, G, bid);
                    EpiSsmA E{YI, SB}; pg8::gemm_phase(C.lds, 256, 256, 256, S, E);
                }
#endif
#if (MIXSEL >> 5) & 1
                {
                    pg8::Sched S; S.init(YF, WFO, MT / 256, 4, 1, 512, 512, 0, 0, G, bid);
                    EpiFo E{SGF}; pg8::gemm_phase(C.lds, 512, 512, 512, S, E);
                }
#endif
                GRID_SYNC(); CTX_REFRESH(C);
                ssm_scan_phase(C, P, SB, HIN);
                GRID_SYNC(); CTX_REFRESH(C);
#if (MIXSEL >> 6) & 1
                {
                    pg8::Sched S; S.init(HIN, WSB, 9, 1, 32, 256, 256, (size_t)UROWS * 256, (size_t)256 * 256, G, bid);
                    EpiSsmB E{YI, YS}; pg8::gemm_phase(C.lds, 256, 256, 256, S, E);
                }
#endif
                GRID_SYNC(); CTX_REFRESH(C);
#if defined(DUMP) && DUMP == 2
                dump_phase(C, YS, SGF, args.out); return;
#endif
#if (MIXSEL >> 7) & 1
                {
                    pg8::Sched S; S.init(YS, WGLU, MT / 256, 4, 1, 512, 512, 0, 0, G, bid);
                    EpiPair<1> E{ZG, 512}; pg8::gemm_phase(C.lds, 512, 512, 512, S, E);
                }
#endif
                GRID_SYNC(); CTX_REFRESH(C);
#if (MIXSEL >> 8) & 1
                {
                    pg8::Sched S; S.init(ZG, WSSO, MT / 256, 4, 1, 512, 512, 0, 0, G, bid);
                    EpiSso E{SGS, SGF}; pg8::gemm_phase(C.lds, 512, 512, 512, S, E);
                }
#endif
                GRID_SYNC(); CTX_REFRESH(C);
#if (MIXSEL >> 9) & 1
                {
                    pg8::Sched S; S.init(SGS, WOUT, MT / 256, 4, 1, 1024, 1024, 0, 0, G, bid);
                    EpiRes E{H, MODl + 5 * 1024, 1.0f}; pg8::gemm_phase(C.lds, 1024, 1024, 1024, S, E);
                }
#endif
                GRID_SYNC(); CTX_REFRESH(C);
            }
#endif
#ifndef NO_FFN
            const int kb = f == 0 ? 0 : 6;
            norm_phase(C, H, MODl, normg + (l * 3 + (f == 0 ? 0 : 2)) * 1024, kb, AN_FFN);
            GRID_SYNC(); CTX_REFRESH(C);
            {
                pg8::Sched S; S.init(AN_FFN, W13, MT / 256, 22, 1, 1024, 1024, 0, 0, G, bid);
                EpiPair<0> E{HID, DFF}; pg8::gemm_phase(C.lds, 1024, 1024, 1024, S, E);
            }
            GRID_SYNC(); CTX_REFRESH(C);
            {
                pg8::Sched S; S.init(HID, W2, MT / 256, 4, 1, DFF, DFF, 0, 0, G, bid);
                EpiRes E{H, MODl + (kb + 2) * 1024, 0.5f}; pg8::gemm_phase(C.lds, DFF, DFF, DFF, S, E);
            }
            GRID_SYNC(); CTX_REFRESH(C);
#endif
        }
    }
    final_norm_phase(C, H, fing, args.out);
}

extern "C" void kernel_launch(void* const* d_in, const int* in_sizes, int n_in, void* d_out, int out_size, void* d_ws, size_t ws_size, hipStream_t stream) {
    static int grid = 0;
    if (grid == 0) {
        if (n_in != 25 || ws_size < WS_END) { fprintf(stderr, "kernel_launch: bad n_in %d or ws_size %zu < %zu\n", n_in, ws_size, (size_t)WS_END); grid = -1; return; }
        int dev = 0, cus = 0, per_cu = 0;
        (void)hipGetDevice(&dev);
        (void)hipDeviceGetAttribute(&cus, hipDeviceAttributeMultiprocessorCount, dev);
        (void)hipFuncSetAttribute((const void*)fwd_mega, hipFuncAttributeMaxDynamicSharedMemorySize, LDS_BYTES);
        (void)hipOccupancyMaxActiveBlocksPerMultiprocessor(&per_cu, (const void*)fwd_mega, 512, LDS_BYTES);
        if (per_cu < 1) per_cu = 1;
        grid = cus * 1;
        fprintf(stderr, "kernel_launch: grid %d (cus %d, per_cu %d), ws %zu\n", grid, cus, per_cu, ws_size);
    }
    if (grid < 0) return;
    Args a{};
    for (int i = 0; i < 25; ++i) a.in[i] = (const float*)d_in[i];
    a.out = (float*)d_out; a.ws = (unsigned char*)d_ws;
    void* kargs[] = {&a};
    hipError_t e = hipLaunchCooperativeKernel((const void*)fwd_mega, dim3(grid), dim3(512), kargs, LDS_BYTES, stream);
    if (e != hipSuccess) fprintf(stderr, "kernel_launch: cooperative launch failed: %s\n", hipGetErrorString(e));
}
```

```cpp
#include <hip/hip_runtime.h>
#include <hip/hip_cooperative_groups.h>
#include <cstdio>
#include <cstdint>
namespace cg = cooperative_groups;
#ifndef MIXSEL
#define MIXSEL 0xffff
#endif

#define LAS __attribute__((address_space(3)))
typedef unsigned short bf16_t;
typedef short bf16x8 __attribute__((ext_vector_type(8)));
typedef float f32x4 __attribute__((ext_vector_type(4)));
typedef float f32x2 __attribute__((ext_vector_type(2)));
typedef unsigned u32x4 __attribute__((ext_vector_type(4)));
typedef unsigned u32x2 __attribute__((ext_vector_type(2)));

constexpr int DM = 1024, NB = 8, SEQ = 4096, CTX = 256, DEPTH = 4, DFF = 2816;
constexpr int ML = NB * SEQ, MC = NB * CTX, MT = ML + MC;
constexpr int NMOD = 9 * DM;
constexpr int UROWS = 2304;

constexpr size_t MiB = 1u << 20;
constexpr size_t WS_H = 0;
constexpr size_t WS_X = 136 * MiB;
constexpr size_t X_HID = WS_X;
constexpr size_t X_AN_FFN = WS_X + 276 * MiB;
constexpr size_t X_VT2 = WS_X;
constexpr size_t X_VT2C = WS_X + 64 * MiB;
constexpr size_t X_SGF = WS_X + 68 * MiB;
constexpr size_t X_SGS = WS_X + 136 * MiB;
constexpr size_t X_UG = WS_X + 204 * MiB;
constexpr size_t X_S = WS_X + 240 * MiB;
constexpr size_t X_AN_MIX = X_S;
constexpr size_t X_YS = X_S;
constexpr size_t X_ZG = X_S + 34 * MiB;
constexpr size_t X_YF = WS_X + 312 * MiB;
constexpr size_t X_YI = WS_X;
constexpr size_t X_MODP = WS_X;
constexpr size_t WS_DFT = 482 * MiB;
constexpr size_t WS_DFTC = 546 * MiB;
constexpr size_t WS_W = 547 * MiB;
constexpr size_t W_13 = WS_W;
constexpr size_t W_2 = WS_W + 11 * MiB;
constexpr size_t W_IN = WS_W + 17 * MiB;
constexpr size_t W_FO = WS_W + 24 * MiB;
constexpr size_t W_GLU = WS_W + 25 * MiB;
constexpr size_t W_SSO = WS_W + 26 * MiB;
constexpr size_t W_OUT = WS_W + 27 * MiB;
constexpr size_t W_SA = WS_W + 29 * MiB;
constexpr size_t W_SB = WS_W + 37 * MiB;
constexpr size_t WS_MOD = 588 * MiB;
constexpr size_t WS_PART = WS_X + 204 * MiB;
constexpr size_t WS_GS = WS_MOD + 1408 * 1024;
constexpr size_t WS_R = WS_MOD + 1856 * 1024;
constexpr size_t WS_ROWSQ = 590 * MiB;
constexpr size_t WS_BIASF = 592 * MiB + 256 * 1024;
constexpr size_t WS_BIASM = 592 * MiB + 512 * 1024;
constexpr size_t WS_END = 594 * MiB;

constexpr int LDS_BYTES = 139264;

__device__ __forceinline__ unsigned cvt_pk_bf16(float lo, float hi) { unsigned r; asm volatile("s_nop 1\n\tv_cvt_pk_bf16_f32 %0, %1, %2" : "=v"(r) : "v"(lo), "v"(hi)); return r; }
__device__ __forceinline__ float bf_lo(unsigned w) { return __uint_as_float(w << 16); }
__device__ __forceinline__ float bf_hi(unsigned w) { return __uint_as_float(w & 0xffff0000u); }
__device__ __forceinline__ float sigmoidf_(float x) { return __builtin_amdgcn_rcpf(1.f + __expf(-x)); }
__device__ __forceinline__ float siluf_(float x) { return x * sigmoidf_(x); }
__device__ __forceinline__ float gelu_tanh(float y) { const float u = 0.7978845608028654f * (y + 0.044715f * y * y * y); return y * sigmoidf_(2.f * u); }
__device__ __forceinline__ float wave_sum(float v) {
#pragma unroll
    for (int o = 1; o < 64; o <<= 1) v += __shfl_xor(v, o);
    return v;
}
__device__ __forceinline__ u32x4 pack8(const float (&r)[8]) { u32x4 w; w.x = cvt_pk_bf16(r[0], r[1]); w.y = cvt_pk_bf16(r[2], r[3]); w.z = cvt_pk_bf16(r[4], r[5]); w.w = cvt_pk_bf16(r[6], r[7]); return w; }
__device__ __forceinline__ void unpack8(const u32x4 w, float (&r)[8]) { r[0] = bf_lo(w.x); r[1] = bf_hi(w.x); r[2] = bf_lo(w.y); r[3] = bf_hi(w.y); r[4] = bf_lo(w.z); r[5] = bf_hi(w.z); r[6] = bf_lo(w.w); r[7] = bf_hi(w.w); }

namespace pg8 {
constexpr int BM = 256, BK = 64, HALF = 128, HTB = HALF * BK * 2, STAGE_BYTES = 8 * HTB, NXCD = 8, WGM = 8;
__host__ __device__ __forceinline__ int lds_byte(int r, int c) { const int st = (r >> 4) * 2 + (c >> 5), rr = r & 15, cc = c & 31, ob = rr * 64 + cc * 2; return st * 1024 + (ob ^ (((ob >> 9) & 1) << 5)); }
__host__ __device__ __forceinline__ void stage_rc(int b, int& R, int& C) { const int st = b / 1024, sb = b % 1024, swz = sb ^ (((sb >> 9) & 1) << 5); R = (st >> 1) * 16 + swz / 64; C = (st & 1) * 32 + (swz % 64) / 2; }
__host__ __device__ __forceinline__ int perm32(int rho) { const int n = rho >> 4, i = rho & 15; return 8 * (i >> 2) + 4 * n + (i & 3); }

struct Unit { int pm, pn, z; const char* a; const char* b; };

struct Sched {
    int nM, nN, nwg, G, c, per_z; const char* A; const char* B; size_t tA, tB, zA, zB;
    __device__ __forceinline__ void init(const void* A_, const void* B_, int nM_, int nN_, int nZ, size_t lda, size_t ldb, size_t zA_el, size_t zB_el, int G_, int c_) {
        A = (const char*)A_; B = (const char*)B_; nM = nM_; nN = nN_; per_z = nM_ * nN_; nwg = per_z * nZ; G = G_; c = c_;
        tA = (size_t)BM * lda * 2; tB = (size_t)BM * ldb * 2; zA = zA_el * 2; zB = zB_el * 2;
    }
    __device__ __forceinline__ bool next(int i, Unit& u) const {
        const long L = (long)i * G + c; if (L >= nwg) return false;
        int wgid = (int)L; { const int q = nwg / NXCD, r = nwg % NXCD, xcd = wgid % NXCD, off = wgid / NXCD; wgid = (xcd < r ? xcd * (q + 1) : r * (q + 1) + (xcd - r) * q) + off; }
        const int z = wgid / per_z, w = wgid % per_z;
        const int nig = WGM * nN, gid = w / nig, fm = gid * WGM, gsz = (nM - fm) < WGM ? (nM - fm) : WGM;
        u.pm = fm + ((w % nig) % gsz); u.pn = (w % nig) / gsz; u.z = z;
        u.a = A + (size_t)z * zA + (size_t)u.pm * tA; u.b = B + (size_t)z * zB + (size_t)u.pn * tB; return true;
    }
};

template <class Epi>
__device__ __forceinline__ void gemm_phase(LAS unsigned char* lds, const int wave_id, const int K_, const int lda_, const int ldb_, const Sched& S, const Epi& E) {
    int K = K_, lda = lda_, ldb = ldb_; asm volatile("" : "+s"(K), "+s"(lda), "+s"(ldb));
    const int lane = (int)__builtin_amdgcn_mbcnt_hi(~0u, __builtin_amdgcn_mbcnt_lo(~0u, 0u));
    int tid = (wave_id << 6) | lane; asm volatile("" : "+v"(tid));
    const int wid = wave_id, wr = wid >> 2, wc = wid & 3, fr = lane & 15, fq = lane >> 4;
    const int nt = K / BK;
    unsigned voffA[2], voffB[2];
#pragma unroll
    for (int i = 0; i < 2; ++i) { int R, C; stage_rc(tid * 16 + i * 8192, R, C); const int Rb = (R & ~31) + perm32(R & 31);
        voffA[i] = (unsigned)(R * lda + C) * 2u; voffB[i] = (unsigned)(Rb * ldb + C) * 2u; }
    const size_t kstep = (size_t)(BK * 2);
    const size_t hstepA = (size_t)HALF * lda * 2, hstepB = (size_t)HALF * ldb * 2;
    const unsigned ldsw = (unsigned)wid * 1024u;
    const int aoff = lds_byte(wr * 64 + fr, fq * 8), boff = lds_byte(wc * 32 + fr, fq * 8);
#define PG8_SA(b, h) (((b) * 2 + (h)) * HTB)
#define PG8_SB(b, h) ((4 + (b) * 2 + (h)) * HTB)
#define PG8_STAGE(bufoff, gbase, voff) do { const char* _g = (const char*)(gbase); asm volatile("" : "+s"(_g)); _Pragma("unroll") for (int _i = 0; _i < 2; ++_i) \
        __builtin_amdgcn_global_load_lds((const unsigned*)(_g + (voff)[_i]), (LAS unsigned*)(lds + (bufoff) + ldsw + _i * 8192), 16, 0, 0); } while (0)
#define PG8_LDA(dst, b, h) do { _Pragma("unroll") for (int m = 0; m < 4; ++m) _Pragma("unroll") for (int k = 0; k < 2; ++k) dst[m][k] = *(const LAS bf16x8*)(lds + PG8_SA(b, h) + aoff + m * 2048 + k * 1024); } while (0)
#define PG8_LDB(dst, b, h) do { _Pragma("unroll") for (int n = 0; n < 2; ++n) _Pragma("unroll") for (int k = 0; k < 2; ++k) dst[n][k] = *(const LAS bf16x8*)(lds + PG8_SB(b, h) + boff + n * 2048 + k * 1024); } while (0)
#define PG8_MMA(ai, bj, At, Bt) do { __builtin_amdgcn_s_setprio(1); _Pragma("unroll") for (int m = 0; m < 4; ++m) _Pragma("unroll") for (int n = 0; n < 2; ++n) _Pragma("unroll") for (int k = 0; k < 2; ++k) \
        acc[ai][bj][m][n] = __builtin_amdgcn_mfma_f32_16x16x32_bf16(Bt[n][k], At[m][k], acc[ai][bj][m][n], 0, 0, 0); __builtin_amdgcn_s_setprio(0); } while (0)
#define PG8_WAIT_V(n) asm volatile("s_waitcnt vmcnt(" #n ")" ::: "memory")
#define PG8_WAIT_L(n) asm volatile("s_waitcnt lgkmcnt(" #n ")" ::: "memory")
#define PG8_BAR __builtin_amdgcn_s_barrier()
#define PG8_SCHED __builtin_amdgcn_sched_barrier(0)
    Unit cur, nxt; int ui = 0;
    if (!S.next(0, cur)) return;
    f32x4 acc[2][2][4][2];
#pragma unroll
    for (int a = 0; a < 2; ++a)
#pragma unroll
        for (int b = 0; b < 2; ++b)
#pragma unroll
            for (int m = 0; m < 4; ++m)
#pragma unroll
                for (int n = 0; n < 2; ++n) acc[a][b][m][n] = (f32x4){0.f, 0.f, 0.f, 0.f};
    bf16x8 At[4][2], B0[2][2], B1[2][2];
    const char* cA = cur.a; const char* cB = cur.b;
    PG8_STAGE(PG8_SB(0, 0), cB, voffB); PG8_STAGE(PG8_SB(0, 1), cB + hstepB, voffB); PG8_STAGE(PG8_SA(0, 0), cA, voffA); PG8_STAGE(PG8_SA(0, 1), cA + hstepA, voffA);
    if (wr == 1) PG8_BAR;
    PG8_WAIT_V(2); PG8_BAR;
    PG8_STAGE(PG8_SB(1, 0), cB + kstep, voffB); PG8_STAGE(PG8_SA(1, 0), cA + kstep, voffA); PG8_STAGE(PG8_SB(1, 1), cB + hstepB + kstep, voffB);
    PG8_WAIT_V(6); PG8_BAR;
    for (;;) {
        const bool has_next = S.next(ui + 1, nxt);
        const char* nA = has_next ? nxt.a : cA; const char* nB = has_next ? nxt.b : cB;
        for (int t = 0; t < nt; t += 2) {
            const bool last = (t == nt - 2);
            const char* a1 = cA + (size_t)(t + 1) * kstep;
            const char* a2 = last ? nA : cA + (size_t)(t + 2) * kstep; const char* b2 = last ? nB : cB + (size_t)(t + 2) * kstep;
            const char* a3 = a2 + kstep; const char* b3 = b2 + kstep;
            PG8_LDB(B0, 0, 0); PG8_LDB(B1, 0, 1); PG8_SCHED; PG8_LDA(At, 0, 0); PG8_STAGE(PG8_SA(1, 1), a1 + hstepA, voffA);
            PG8_WAIT_V(8); PG8_WAIT_L(0); PG8_BAR; PG8_MMA(0, 0, At, B0); PG8_MMA(0, 1, At, B1); PG8_BAR; PG8_SCHED;
            PG8_LDA(At, 0, 1); PG8_STAGE(PG8_SB(0, 0), b2, voffB); PG8_STAGE(PG8_SB(0, 1), b2 + hstepB, voffB); PG8_STAGE(PG8_SA(0, 0), a2, voffA);
            PG8_WAIT_V(8); PG8_WAIT_L(0); PG8_BAR; PG8_MMA(1, 0, At, B0); PG8_MMA(1, 1, At, B1); PG8_BAR; PG8_SCHED;
            PG8_LDB(B0, 1, 0); PG8_LDB(B1, 1, 1); PG8_SCHED; PG8_LDA(At, 1, 0); PG8_STAGE(PG8_SA(0, 1), a2 + hstepA, voffA);
            PG8_WAIT_V(8); PG8_WAIT_L(0); PG8_BAR; PG8_MMA(0, 0, At, B0); PG8_MMA(0, 1, At, B1); PG8_BAR; PG8_SCHED;
            PG8_LDA(At, 1, 1); PG8_STAGE(PG8_SB(1, 0), b3, voffB); PG8_STAGE(PG8_SB(1, 1), b3 + hstepB, voffB); PG8_STAGE(PG8_SA(1, 0), a3, voffA);
            PG8_WAIT_V(8); PG8_WAIT_L(0); PG8_BAR; PG8_MMA(1, 0, At, B0); PG8_MMA(1, 1, At, B1); PG8_BAR; PG8_SCHED;
        }
        if (wr == 0) PG8_BAR;
        { int fr2 = fr, fq2 = fq; asm volatile("" : "+v"(fr2), "+v"(fq2)); E(acc, cur, wr, wc, fr2, fq2); }
        if (!has_next) break;
#pragma unroll
        for (int a = 0; a < 2; ++a)
#pragma unroll
            for (int b = 0; b < 2; ++b)
#pragma unroll
                for (int m = 0; m < 4; ++m)
#pragma unroll
                    for (int n = 0; n < 2; ++n) acc[a][b][m][n] = (f32x4){0.f, 0.f, 0.f, 0.f};
        cur = nxt; cA = nA; cB = nB; ++ui;
        if (wr == 1) PG8_BAR;
    }
    PG8_WAIT_V(0);
    PG8_BAR;
#undef PG8_SA
#undef PG8_SB
#undef PG8_STAGE
#undef PG8_LDA
#undef PG8_LDB
#undef PG8_MMA
#undef PG8_WAIT_V
#undef PG8_WAIT_L
#undef PG8_BAR
#undef PG8_SCHED
}
}
using pg8::Unit;
typedef f32x4 AccT[2][2][4][2];

#define EPI_ROWS_BEGIN _Pragma("unroll") for (int ai = 0; ai < 2; ++ai) _Pragma("unroll") for (int m = 0; m < 4; ++m) { const int row = u.pm * 256 + ai * 128 + wr * 64 + m * 16 + fr;
#define EPI_ROWS_END if (m & 1) asm volatile("" ::: "memory"); }
#define EPI_LOAD_R(R) float rr8[2][4]; _Pragma("unroll") for (int ai = 0; ai < 2; ++ai) _Pragma("unroll") for (int m = 0; m < 4; ++m) rr8[ai][m] = (R)[u.pm * 256 + ai * 128 + wr * 64 + m * 16 + fr];
#define ACC8(dst, ai, bj, m) { const f32x4 _a = acc[ai][bj][m][0], _b = acc[ai][bj][m][1]; dst[0] = _a[0]; dst[1] = _a[1]; dst[2] = _a[2]; dst[3] = _a[3]; dst[4] = _b[0]; dst[5] = _b[1]; dst[6] = _b[2]; dst[7] = _b[3]; }

template <int MODE  > struct EpiPair {
    bf16_t* O; int ldo; const float* R; const float* BIAS;
    __device__ __forceinline__ void operator()(const AccT& acc, const Unit& u, int wr, int wc, int fr, int fq) const {
        const int col = u.pn * 128 + wc * 32 + 8 * fq;
        f32x4 ba0, ba1, bb0, bb1; float rr8[2][4];
        if (MODE == 0) {
            const int rt = u.pm * 256; const float* bp = BIAS + (rt < ML ? (rt >> 12) : 8) * 5632 + u.pn * 256 + wc * 32 + 8 * fq;
            ba0 = *(const f32x4*)bp; ba1 = *(const f32x4*)(bp + 4); bb0 = *(const f32x4*)(bp + 128); bb1 = *(const f32x4*)(bp + 132);
#pragma unroll
            for (int ai = 0; ai < 2; ++ai)
#pragma unroll
                for (int m = 0; m < 4; ++m) rr8[ai][m] = R[rt + ai * 128 + wr * 64 + m * 16 + fr];
        }
        EPI_ROWS_BEGIN
            float a[8], b[8], r[8]; ACC8(a, ai, 0, m); ACC8(b, ai, 1, m);
            if (MODE == 0) {
                const float rr = rr8[ai][m];
#pragma unroll
                for (int j = 0; j < 4; ++j) { a[j] = rr * a[j] + ba0[j]; a[4 + j] = rr * a[4 + j] + ba1[j]; b[j] = rr * b[j] + bb0[j]; b[4 + j] = rr * b[4 + j] + bb1[j]; }
            }
#pragma unroll
            for (int j = 0; j < 8; ++j) r[j] = MODE == 0 ? siluf_(a[j]) * b[j] : a[j] * sigmoidf_(b[j]);
            *(u32x4*)(O + (size_t)row * ldo + col) = pack8(r);
        EPI_ROWS_END
    }
};
template <bool SLICE, bool HALFSTEP> struct EpiRes {
    float* H; const float* gate; float* PART; const float* GS; bf16_t* AN; float* ROWSQ;
    __device__ __forceinline__ void operator()(const AccT& acc, const Unit& u, int wr, int wc, int fr, int fq) const {
        constexpr float sc = HALFSTEP ? 0.5f : 1.0f; constexpr int row0 = SLICE ? ML : 0;
        const int rt = row0 + u.pm * 256, bi = rt < ML ? (rt >> 12) : 8;
        f32x4 gq[2][2], sq[2][2];
#pragma unroll
        for (int bj = 0; bj < 2; ++bj) { const int col = u.pn * 256 + bj * 128 + wc * 32 + 8 * fq;
            const float* gp = gate + bi * NMOD + col; gq[bj][0] = *(const f32x4*)gp * sc; gq[bj][1] = *(const f32x4*)(gp + 4) * sc;
            if (!SLICE) { const float* gsp = GS + bi * DM + col; sq[bj][0] = *(const f32x4*)gsp; sq[bj][1] = *(const f32x4*)(gsp + 4); } }
        EPI_ROWS_BEGIN
            const int grow = row0 + row;
            float ss = 0.f;
#pragma unroll
            for (int bj = 0; bj < 2; ++bj) {
                const int col = u.pn * 256 + bj * 128 + wc * 32 + 8 * fq;
                float* p = H + (size_t)grow * DM + col;
                const f32x4 d0 = gq[bj][0] * acc[ai][bj][m][0], d1 = gq[bj][1] * acc[ai][bj][m][1];
                if (SLICE) {
                    float* pp = PART + ((size_t)u.z * MC + (grow - ML)) * DM + col;
                    *(f32x4*)pp = d0; *(f32x4*)(pp + 4) = d1;
                } else {
                    f32x4 h0 = *(const f32x4*)p, h1 = *(const f32x4*)(p + 4);
                    h0 += d0; h1 += d1;
                    *(f32x4*)p = h0; *(f32x4*)(p + 4) = h1;
                    ss += (h0[0] * h0[0] + h0[1] * h0[1]) + (h0[2] * h0[2] + h0[3] * h0[3]) + (h1[0] * h1[0] + h1[1] * h1[1]) + (h1[2] * h1[2] + h1[3] * h1[3]);
                    h0 *= sq[bj][0]; h1 *= sq[bj][1];
                    float r[8] = {h0[0], h0[1], h0[2], h0[3], h1[0], h1[1], h1[2], h1[3]};
                    *(u32x4*)(AN + (size_t)grow * DM + col) = pack8(r);
                }
            }
            if (!SLICE) { ss += __shfl_xor(ss, 16); ss += __shfl_xor(ss, 32); if (fq == 0) ROWSQ[(size_t)grow * 16 + u.pn * 4 + wc] = ss; }
        EPI_ROWS_END
    }
};
struct EpiInT {
    bf16_t* VT2; bf16_t* VT2C; const float* R; const float* BIAS;
    __device__ __forceinline__ void operator()(const AccT& acc, const Unit& u, int wr, int wc, int fr, int fq) const {
        const int mt0 = u.pn * 256; const float* bb = BIAS + (mt0 < ML ? (mt0 >> 12) : 8) * 3584;
        f32x4 rr[2][2];
#pragma unroll
        for (int bj = 0; bj < 2; ++bj) { const float* rp = R + mt0 + bj * 128 + wc * 32 + 8 * fq; rr[bj][0] = *(const f32x4*)rp; rr[bj][1] = *(const f32x4*)(rp + 4); }
        EPI_LOAD_R(bb)
        EPI_ROWS_BEGIN
            const int grp = row >> 8, part = (row >> 7) & 1, ch = grp * 128 + (row & 127); const float bv = rr8[ai][m];
#pragma unroll
            for (int bj = 0; bj < 2; ++bj) {
                const int m0 = mt0 + bj * 128 + wc * 32 + 8 * fq;
                const f32x4 v0 = acc[ai][bj][m][0] * rr[bj][0] + bv, v1 = acc[ai][bj][m][1] * rr[bj][1] + bv;
                float r[8] = {v0[0], v0[1], v0[2], v0[3], v1[0], v1[1], v1[2], v1[3]};
                bf16_t* dst;
                if (m0 < ML) { const int b = m0 >> 12, t = m0 & 4095; dst = VT2 + ((size_t)(b * 512 + ch) * 8192 + part * 4096 + t); }
                else { const int mm = m0 - ML, b = mm >> 8, t = mm & 255; dst = VT2C + ((size_t)(b * 512 + ch) * 512 + part * 256 + t); }
                *(u32x4*)dst = pack8(r);
            }
        EPI_ROWS_END
    }
};
struct EpiInU {
    bf16_t* UG; const float* R; const float* BIAS;
    __device__ __forceinline__ void operator()(const AccT& acc, const Unit& u, int wr, int wc, int fr, int fq) const {
        const int rt = u.pm * 256; const float* bb = BIAS + (rt < ML ? (rt >> 12) : 8) * 3584 + 1024;
        f32x4 bq[2][2];
#pragma unroll
        for (int bj = 0; bj < 2; ++bj) { const int c = u.pn * 256 + bj * 128 + wc * 32 + 8 * fq; bq[bj][0] = *(const f32x4*)(bb + c); bq[bj][1] = *(const f32x4*)(bb + c + 4); }
        EPI_LOAD_R(R)
        EPI_ROWS_BEGIN
            int urow, ii;
            if (row < ML) { const int b = row >> 12, t = row & 4095; urow = b * 256 + (t >> 4); ii = t & 15; }
            else { const int mm = row - ML, b = mm >> 8, t = mm & 255; urow = 2048 + b * 16 + (t >> 4); ii = t & 15; }
            const float rr = rr8[ai][m];
#pragma unroll
            for (int bj = 0; bj < 2; ++bj) {
                const int c = u.pn * 256 + bj * 128 + wc * 32 + 8 * fq, g = c >> 4, h0 = c & 15;
                const f32x4 v0 = acc[ai][bj][m][0] * rr + bq[bj][0], v1 = acc[ai][bj][m][1] * rr + bq[bj][1];
                float r[8] = {v0[0], v0[1], v0[2], v0[3], v1[0], v1[1], v1[2], v1[3]};
                *(u32x4*)(UG + ((size_t)(g * UROWS + urow) * 256 + ii * 16 + h0)) = pack8(r);
            }
        EPI_ROWS_END
    }
};
struct EpiInG {
    bf16_t* SGF; bf16_t* SGS; const float* R; const float* BIAS;
    __device__ __forceinline__ void operator()(const AccT& acc, const Unit& u, int wr, int wc, int fr, int fq) const {
        bf16_t* base = u.pn < 4 ? SGF : SGS; const int c0 = (u.pn & 3) * 256 + wc * 32 + 8 * fq, cb = 1536 + u.pn * 256 + wc * 32 + 8 * fq;
        const int rt = u.pm * 256; const float* bb = BIAS + (rt < ML ? (rt >> 12) : 8) * 3584 + cb;
        f32x4 bq[2][2];
#pragma unroll
        for (int bj = 0; bj < 2; ++bj) { bq[bj][0] = *(const f32x4*)(bb + bj * 128); bq[bj][1] = *(const f32x4*)(bb + bj * 128 + 4); }
        EPI_LOAD_R(R)
        EPI_ROWS_BEGIN
            const float rr = rr8[ai][m];
#pragma unroll
            for (int bj = 0; bj < 2; ++bj) {
                const f32x4 v0 = acc[ai][bj][m][0] * rr + bq[bj][0], v1 = acc[ai][bj][m][1] * rr + bq[bj][1];
                float r[8] = {v0[0], v0[1], v0[2], v0[3], v1[0], v1[1], v1[2], v1[3]};
#pragma unroll
                for (int j = 0; j < 8; ++j) r[j] = sigmoidf_(r[j]);
                *(u32x4*)(base + (size_t)row * DM + c0 + bj * 128) = pack8(r);
            }
        EPI_ROWS_END
    }
};
struct EpiF2 {
    bf16_t* O; int rbase, zrows, ldo;
    __device__ __forceinline__ void operator()(const AccT& acc, const Unit& u, int wr, int wc, int fr, int fq) const {
        EPI_ROWS_BEGIN
            const size_t orow = (size_t)(rbase + u.z * zrows + row);
#pragma unroll
            for (int bj = 0; bj < 2; ++bj) { float r[8]; ACC8(r, ai, bj, m); *(u32x4*)(O + orow * ldo + u.pn * 256 + bj * 128 + wc * 32 + 8 * fq) = pack8(r); }
        EPI_ROWS_END
    }
};
struct EpiSsmA {
    bf16_t* YI; float* S;
    __device__ __forceinline__ void operator()(const AccT& acc, const Unit& u, int wr, int wc, int fr, int fq) const {
        EPI_ROWS_BEGIN
            const size_t base = ((size_t)u.z * UROWS + row) * 256;
#pragma unroll
            for (int bj = 0; bj < 2; ++bj) {
                const int col = bj * 128 + wc * 32 + 8 * fq;
                if (u.pn == 0) { float r[8]; ACC8(r, ai, bj, m); *(u32x4*)(YI + base + col) = pack8(r); }
                else { *(f32x4*)(S + base + col) = acc[ai][bj][m][0]; *(f32x4*)(S + base + col + 4) = acc[ai][bj][m][1]; }
            }
        EPI_ROWS_END
    }
};
struct EpiSsmB {
    const bf16_t* YI; bf16_t* YS;
    __device__ __forceinline__ void operator()(const AccT& acc, const Unit& u, int wr, int wc, int fr, int fq) const {
        EPI_ROWS_BEGIN
            int tok0;
            if (row < 2048) tok0 = (row >> 8) * 4096 + (row & 255) * 16;
            else { const int rr = row - 2048; tok0 = ML + (rr >> 4) * 256 + (rr & 15) * 16; }
            if (row < 2176) {
                const size_t base = ((size_t)u.z * UROWS + row) * 256;
#pragma unroll
                for (int bj = 0; bj < 2; ++bj) {
                    const int col = bj * 128 + wc * 32 + 8 * fq, j = col >> 4, h0 = col & 15;
                    float r[8], yi[8]; ACC8(r, ai, bj, m); unpack8(*(const u32x4*)(YI + base + col), yi);
#pragma unroll
                    for (int q = 0; q < 8; ++q) r[q] = gelu_tanh(r[q] + yi[q]);
                    *(u32x4*)(YS + (size_t)(tok0 + j) * 512 + u.z * 16 + h0) = pack8(r);
                }
            }
        EPI_ROWS_END
    }
};
struct EpiFo {
    bf16_t* SGF;
    __device__ __forceinline__ void operator()(const AccT& acc, const Unit& u, int wr, int wc, int fr, int fq) const {
        EPI_ROWS_BEGIN
#pragma unroll
            for (int bj = 0; bj < 2; ++bj) {
                bf16_t* p = SGF + (size_t)row * DM + u.pn * 256 + bj * 128 + wc * 32 + 8 * fq;
                float r[8], g[8]; ACC8(r, ai, bj, m); unpack8(*(const u32x4*)p, g);
#pragma unroll
                for (int q = 0; q < 8; ++q) r[q] *= g[q];
                *(u32x4*)p = pack8(r);
            }
        EPI_ROWS_END
    }
};
struct EpiSso {
    bf16_t* SGS; const bf16_t* MG1;
    __device__ __forceinline__ void operator()(const AccT& acc, const Unit& u, int wr, int wc, int fr, int fq) const {
        EPI_ROWS_BEGIN
#pragma unroll
            for (int bj = 0; bj < 2; ++bj) {
                const size_t off = (size_t)row * DM + u.pn * 256 + bj * 128 + wc * 32 + 8 * fq;
                float r[8], g[8], f[8]; ACC8(r, ai, bj, m); unpack8(*(const u32x4*)(SGS + off), g); unpack8(*(const u32x4*)(MG1 + off), f);
#pragma unroll
                for (int q = 0; q < 8; ++q) r[q] = f[q] + g[q] * r[q];
                *(u32x4*)(SGS + off) = pack8(r);
            }
        EPI_ROWS_END
    }
};

struct Ctx { LAS unsigned char* lds; int tid, lane, wave, G, bid, gw, NGW; };
#define CTX_REFRESH(C) do { int _t = ((C).wave << 6) | (int)__builtin_amdgcn_mbcnt_hi(~0u, __builtin_amdgcn_mbcnt_lo(~0u, 0u)); asm volatile("" : "+v"(_t)); (C).tid = _t; (C).lane = _t & 63; int _g = (C).gw; asm volatile("" : "+s"(_g)); (C).gw = _g; } while (0)

__device__ __forceinline__ void transpose_item(const Ctx& C, const float* W, int K, int ldw, int n0, int ncols, bf16_t* WT, int mode, int half, int row_off, int item) {
    LAS float* scr = (LAS float*)(C.lds + C.wave * 16384);
    const int nblk = ncols / 32, kb = item / nblk, nb = item % nblk, k0 = 64 * kb, nr0 = 32 * nb, lane = C.lane;
    int r0;
    if (mode == 0) r0 = row_off + nr0;
    else { const int hsel = nr0 >= half ? 1 : 0, j = nr0 - hsel * half; r0 = (j >> 7) * 256 + hsel * 128 + (j & 127); }
#pragma unroll 8
    for (int i = 0; i < 32; ++i) { const int kk = 2 * i + (lane >> 5); scr[kk * 33 + (lane & 31)] = W[(size_t)(k0 + kk) * ldw + n0 + nr0 + (lane & 31)]; }
    asm volatile("s_waitcnt lgkmcnt(0)" ::: "memory");
    const int c = lane & 7;
#pragma unroll
    for (int j = 0; j < 4; ++j) { const int n = (lane >> 3) + 8 * j; const LAS float* s = scr + (8 * c) * 33 + n;
        u32x4 o; o.x = cvt_pk_bf16(s[0 * 33], s[1 * 33]); o.y = cvt_pk_bf16(s[2 * 33], s[3 * 33]); o.z = cvt_pk_bf16(s[4 * 33], s[5 * 33]); o.w = cvt_pk_bf16(s[6 * 33], s[7 * 33]);
        *(u32x4*)(WT + (size_t)(r0 + n) * K + k0 + 8 * c) = o; }
    asm volatile("s_waitcnt lgkmcnt(0)" ::: "memory");
}
__device__ __forceinline__ void transpose_mat(const Ctx& C, const float* W, int K, int ldw, int n0, int ncols, bf16_t* WT, int mode, int half, int row_off) {
    const int items = (K / 64) * (ncols / 32);
    for (int it = C.gw; it < items; it += C.NGW) transpose_item(C, W, K, ldw, n0, ncols, WT, mode, half, row_off, it);
}

__device__ __forceinline__ void fourier_weight_phase(const Ctx& C, const float* Win  , bf16_t* WT) {
    LAS float* Wl = (LAS float*)C.lds; LAS float* ct = Wl + 16 * 129; LAS float* st = ct + 128;
    for (int it = C.bid; it < 256; it += C.G) {
        const int grp = it >> 6, k0 = (it & 63) * 16;
        for (int e = C.tid; e < 16 * 128; e += 512) { const int k = e >> 7, c = e & 127; Wl[k * 129 + c] = Win[(size_t)(k0 + k) * 3072 + grp * 128 + c]; }
        if (C.tid < 128) { float sn, cs; sincosf(6.283185307179586f * (float)C.tid * (1.f / 128.f), &sn, &cs); ct[C.tid] = cs; st[C.tid] = sn; }
        __syncthreads();
        const int k = C.tid & 15, jj = C.tid >> 4;
        float a[8];
#pragma unroll
        for (int i = 0; i < 8; ++i) a[i] = 0.f;
        const int part = jj >> 4, j0 = (jj & 15) * 8; const LAS float* tb = part ? st : ct;
        for (int c = 0; c < 128; ++c) { const float w = Wl[k * 129 + c];
#pragma unroll
            for (int i = 0; i < 8; ++i) a[i] += w * tb[(c * (j0 + i)) & 127]; }
#pragma unroll
        for (int i = 0; i < 8; ++i) { const unsigned pk = cvt_pk_bf16(a[i] * 0.08838834764831845f, 0.f);
            WT[(size_t)(grp * 256 + jj * 8 + i) * 1024 + k0 + k] = (bf16_t)(pk & 0xffffu); }
        __syncthreads();
    }
}

struct SsmP { const float *lre, *lim, *lst, *bre, *bim, *cre, *cim, *dd; };
__device__ __forceinline__ void ssm_mats_phase(const Ctx& C, const SsmP& P, bf16_t* Wa, bf16_t* Wb) {
    LAS float* LP = (LAS float*)C.lds;
    LAS float* BB = LP + 2 * 17 * 64 * 2;
    LAS float* CC = BB + 2 * 64 * 16 * 2;
    LAS float* KK = CC + 2 * 16 * 64 * 2;
    const int tid = C.tid;
    for (int g = (C.bid + C.G - 128) % C.G; g < 32; g += C.G) {
        if (tid < 128) {
            const int d = tid >> 6, p = tid & 63;
            const float dt = expf(P.lst[d * 32 + g]); const float lr = P.lre[(d * 32 + g) * 64 + p], li = P.lim[(d * 32 + g) * 64 + p];
            float l1r = 0.f, l1i = 0.f;
            for (int t = 0; t <= 16; ++t) { const float mag = expf(lr * dt * (float)t); float s, c; sincosf(li * dt * (float)t, &s, &c);
                LP[((d * 17 + t) * 64 + p) * 2] = mag * c; LP[((d * 17 + t) * 64 + p) * 2 + 1] = mag * s; if (t == 1) { l1r = mag * c; l1i = mag * s; } }
            const float nr = l1r - 1.f, ni = l1i, den = lr * lr + li * li;
            const float kr = (nr * lr + ni * li) / den, ki = (ni * lr - nr * li) / den;
            for (int h = 0; h < 16; ++h) { const size_t bi_ = ((size_t)(d * 32 + g) * 64 + p) * 16 + h; const float br = P.bre[bi_], bi = P.bim[bi_];
                BB[((d * 64 + p) * 16 + h) * 2] = kr * br - ki * bi; BB[((d * 64 + p) * 16 + h) * 2 + 1] = kr * bi + ki * br; }
        }
        for (int e = tid; e < 2048; e += 512) { const int d = e >> 10, h = (e >> 6) & 15, p = e & 63; const size_t ci_ = ((size_t)(d * 32 + g) * 16 + h) * 64 + p;
            CC[((d * 64 + p) * 16 + h) * 2] = P.cre[ci_]; CC[((d * 64 + p) * 16 + h) * 2 + 1] = P.cim[ci_]; }
        __syncthreads();
        {
            const int d = tid >> 8, t = (tid >> 4) & 15, h = tid & 15;
            float a[16];
#pragma unroll
            for (int q = 0; q < 16; ++q) a[q] = 0.f;
            for (int p = 0; p < 64; ++p) {
                const float cr = CC[((d * 64 + p) * 16 + h) * 2], ci = CC[((d * 64 + p) * 16 + h) * 2 + 1];
                const float Lr = LP[((d * 17 + t) * 64 + p) * 2], Li = LP[((d * 17 + t) * 64 + p) * 2 + 1];
                const float gr = cr * Lr - ci * Li, gi = cr * Li + ci * Lr;
#pragma unroll
                for (int q = 0; q < 16; ++q) a[q] += gr * BB[((d * 64 + p) * 16 + q) * 2] - gi * BB[((d * 64 + p) * 16 + q) * 2 + 1];
            }
#pragma unroll
            for (int q = 0; q < 16; ++q) KK[((d * 16 + t) * 16 + h) * 16 + q] = a[q];
        }
        __syncthreads();
        bf16_t* wa = Wa + (size_t)g * 512 * 256;
        for (int v = tid; v < 512 * 32; v += 512) {
            const int n = v >> 5, kv = (v & 31) * 8, i = kv >> 4, hp0 = kv & 15;
            float r[8];
            if (n < 256) {
                const int j = n >> 4, h = n & 15;
#pragma unroll
                for (int q = 0; q < 8; ++q) { const int hp = hp0 + q; float x = 0.f;
                    if (j >= i) x += KK[((0 * 16 + (j - i)) * 16 + h) * 16 + hp];
                    if (i >= j) x += KK[((1 * 16 + (i - j)) * 16 + h) * 16 + hp];
                    if (i == j && h == hp) x += P.dd[g * 16 + h];
                    r[q] = x; }
            } else {
                const int qn = n - 256, d = qn >> 7, ri = (qn >> 6) & 1, p = qn & 63, t = d == 0 ? 15 - i : i;
                const float Lr = LP[((d * 17 + t) * 64 + p) * 2], Li = LP[((d * 17 + t) * 64 + p) * 2 + 1];
#pragma unroll
                for (int q = 0; q < 8; ++q) { const int hp = hp0 + q; const float br = BB[((d * 64 + p) * 16 + hp) * 2], bi = BB[((d * 64 + p) * 16 + hp) * 2 + 1];
                    r[q] = ri ? (Lr * bi + Li * br) : (Lr * br - Li * bi); }
            }
            *(u32x4*)(wa + (size_t)n * 256 + kv) = pack8(r);
        }
        bf16_t* wb = Wb + (size_t)g * 256 * 256;
        for (int v = tid; v < 256 * 32; v += 512) {
            const int n = v >> 5, kv = (v & 31) * 8, j = n >> 4, h = n & 15, d = kv >> 7, ri = (kv >> 6) & 1, p0 = kv & 63, e = d == 0 ? j + 1 : 16 - j;
            float r[8];
#pragma unroll
            for (int q = 0; q < 8; ++q) { const int p = p0 + q;
                const float cr = CC[((d * 64 + p) * 16 + h) * 2], ci = CC[((d * 64 + p) * 16 + h) * 2 + 1];
                const float Lr = LP[((d * 17 + e) * 64 + p) * 2], Li = LP[((d * 17 + e) * 64 + p) * 2 + 1];
                r[q] = ri ? -(cr * Li + ci * Lr) : (cr * Lr - ci * Li); }
            *(u32x4*)(wb + (size_t)n * 256 + kv) = pack8(r);
        }
        __syncthreads();
    }
}

__device__ __forceinline__ void ssm_scan_phase(const Ctx& C, const SsmP& P, const float* S, bf16_t* Hin) {
    for (int it = C.bid; it < 256; it += C.G) {
        const int g = it >> 3, b = it & 7;
        if (C.tid < 128) {
            const int d = C.tid >> 6, p = C.tid & 63;
            const float dt = expf(P.lst[d * 32 + g]); const float lr = P.lre[(d * 32 + g) * 64 + p], li = P.lim[(d * 32 + g) * 64 + p];
            const float mag = expf(lr * dt * 16.f); float sn, cs; sincosf(li * dt * 16.f, &sn, &cs);
            const float Ar = mag * cs, Ai = mag * sn;
            float hr = 0.f, hi = 0.f;
            const float* Sg = S + (size_t)g * UROWS * 256 + d * 128 + p; bf16_t* Hg = Hin + (size_t)g * UROWS * 256 + d * 128 + p;
            for (int s0 = 0; s0 < 272; s0 += 16) {
                float sr[16], si[16];
                int rowb, dir;
                if (s0 == 0) { rowb = 2048 + b * 16 + (d ? 15 : 0); dir = d ? -1 : 1; }
                else { rowb = b * 256 + (d ? 271 - s0 : s0 - 16); dir = d ? -1 : 1; }
#pragma unroll
                for (int q = 0; q < 16; ++q) { const size_t o = (size_t)(rowb + dir * q) * 256; sr[q] = Sg[o]; si[q] = Sg[o + 64]; }
#pragma unroll
                for (int q = 0; q < 16; ++q) { const size_t o = (size_t)(rowb + dir * q) * 256;
                    const unsigned pk = cvt_pk_bf16(hr, hi); Hg[o] = (bf16_t)(pk & 0xffffu); Hg[o + 64] = (bf16_t)(pk >> 16);
                    const float nr = Ar * hr - Ai * hi + sr[q], ni = Ar * hi + Ai * hr + si[q]; hr = nr; hi = ni; }
            }
        }
    }
}

__device__ __forceinline__ void mod_partial_phase(const Ctx& C, const float* cvec, const float* cctx, const float* wmod, float* MODP) {
    LAS float* cvs = (LAS float*)C.lds;
    for (int it = C.bid; it < 4 * 18 * 16; it += C.G) {
        const int l = it / 288, rem = it % 288, nb = rem >> 4, kc = rem & 15;
        __syncthreads();
        for (int e = C.tid; e < 576; e += 512) { const int r = e >> 6, k = e & 63; const float v = r < 8 ? cvec[r * 1024 + kc * 64 + k] : cctx[kc * 64 + k]; cvs[e] = v / (1.f + expf(-v)); }
        __syncthreads();
        const int n = nb * 512 + C.tid;
        float a[9];
#pragma unroll
        for (int r = 0; r < 9; ++r) a[r] = 0.f;
        const float* wp = wmod + ((size_t)l * 1024 + kc * 64) * NMOD + n;
#pragma unroll 8
        for (int k = 0; k < 64; ++k) { const float w = wp[(size_t)k * NMOD];
#pragma unroll
            for (int r = 0; r < 9; ++r) a[r] += cvs[r * 64 + k] * w; }
#pragma unroll
        for (int r = 0; r < 9; ++r) MODP[((size_t)(kc * 4 + l) * 9 + r) * NMOD + n] = a[r];
    }
}
__device__ __forceinline__ void mod_final_phase(const Ctx& C, const float* bmod, const float* normg, const float* MODP, float* MOD, float* GS) {
    for (int e = C.bid * 512 + C.tid; e < 4 * 9 * NMOD; e += C.G * 512) {
        const int l = e / (9 * NMOD), r = (e / NMOD) % 9, n = e % NMOD; float a = bmod[l * NMOD + n];
#pragma unroll
        for (int kc = 0; kc < 16; ++kc) a += MODP[(size_t)kc * (4 * 9 * NMOD) + e];
        MOD[e] = a;
        const int j = n >> 10, c = n & 1023;
        if (j % 3 == 1) { const int k = j / 3; GS[((size_t)(l * 3 + k) * 9 + r) * DM + c] = normg[(l * 3 + k) * DM + c] * (1.f + a); }
    }
}
__device__ __forceinline__ void dft_gen_phase(const Ctx& C, bf16_t* DFT, bf16_t* DFTC) {
    LAS float* tab = (LAS float*)C.lds;
    __syncthreads();
    for (int i = C.tid; i < 4096; i += 512) tab[i] = cosf(6.283185307179586f * (float)i * (1.f / 4096.f));
    __syncthreads();
    const size_t nv = (size_t)4096 * 8192 / 8;
    for (size_t v = (size_t)C.bid * 512 + C.tid; v < nv; v += (size_t)C.G * 512) {
        const int k = (int)(v >> 10), kk0 = (int)(v & 1023) * 8, part = kk0 >> 12, t0 = kk0 & 4095;
        float r[8];
#pragma unroll
        for (int q = 0; q < 8; ++q) { const int idx = (k * (t0 + q)) & 4095; r[q] = (part ? -tab[(idx - 1024) & 4095] : tab[idx]) * (1.f / 64.f); }
        *(u32x4*)(DFT + v * 8) = pack8(r);
    }
    for (int v = C.bid * 512 + C.tid; v < 256 * 512 / 8; v += C.G * 512) {
        const int k = v >> 6, kk0 = (v & 63) * 8, part = kk0 >> 8, t0 = kk0 & 255;
        float r[8];
#pragma unroll
        for (int q = 0; q < 8; ++q) { const int idx = ((k * (t0 + q)) & 255) * 16; r[q] = (part ? -tab[(idx - 1024) & 4095] : tab[idx]) * (1.f / 16.f); }
        *(u32x4*)(DFTC + (size_t)v * 8) = pack8(r);
    }
}
__device__ __forceinline__ void fin_rows_phase(const Ctx& C, float* H, const float* GSk, bf16_t* AN, const float* PART, int nslice, const float* ROWSQ, float* R, bool all_rows) {
    for (int m = (all_rows ? 0 : ML) + C.gw; m < MT; m += C.NGW) {
        const int bi = m < ML ? (m >> 12) : 8;
        f32x4* xr = (f32x4*)(H + (size_t)m * DM) + C.lane;
        f32x4 v[4]; float s = 0.f;
#pragma unroll
        for (int j = 0; j < 4; ++j) v[j] = xr[64 * j];
        if (!all_rows) {
            for (int z = 0; z < nslice; ++z) { const f32x4* pr = (const f32x4*)(PART + ((size_t)z * MC + (m - ML)) * DM) + C.lane;
#pragma unroll
                for (int j = 0; j < 4; ++j) v[j] += pr[64 * j]; }
#pragma unroll
            for (int j = 0; j < 4; ++j) xr[64 * j] = v[j];
        }
#pragma unroll
        for (int j = 0; j < 4; ++j) s += (v[j][0] * v[j][0] + v[j][1] * v[j][1]) + (v[j][2] * v[j][2] + v[j][3] * v[j][3]);
        s = wave_sum(s);
        if (C.lane == 0) R[m] = rsqrtf(s * (1.f / 1024.f) + 1e-6f);
#pragma unroll
        for (int j = 0; j < 4; ++j) { const int c = 4 * (C.lane + 64 * j);
            const f32x4 y = v[j] * *(const f32x4*)(GSk + bi * DM + c);
            u32x2 w; w.x = cvt_pk_bf16(y[0], y[1]); w.y = cvt_pk_bf16(y[2], y[3]);
            *(u32x2*)(AN + (size_t)m * DM + c) = w; }
    }
    if (!all_rows)
        for (int m = C.bid * 512 + C.tid; m < ML; m += C.G * 512) {
            const f32x4* q = (const f32x4*)(ROWSQ + (size_t)m * 16); const f32x4 a = q[0], b = q[1], c = q[2], d = q[3];
            const float s = ((a[0] + a[1]) + (a[2] + a[3])) + ((b[0] + b[1]) + (b[2] + b[3])) + ((c[0] + c[1]) + (c[2] + c[3])) + ((d[0] + d[1]) + (d[2] + d[3]));
            R[m] = rsqrtf(s * (1.f / 1024.f) + 1e-6f);
        }
}
__device__ __forceinline__ void bias_phase(const Ctx& C, const bf16_t* Wt, int nrows, const float* shift  , float* BIAS) {
    for (int n = C.gw; n < nrows; n += C.NGW) {
        const u32x4* wp = (const u32x4*)(Wt + (size_t)n * DM + C.lane * 16);
        float w[16]; { float t0[8], t1[8]; unpack8(wp[0], t0); unpack8(wp[1], t1);
#pragma unroll
            for (int q = 0; q < 8; ++q) { w[q] = t0[q]; w[8 + q] = t1[q]; } }
        for (int bi = 0; bi < 9; ++bi) {
            const f32x4* sp = (const f32x4*)(shift + bi * NMOD + C.lane * 16);
            float a = 0.f;
#pragma unroll
            for (int q = 0; q < 4; ++q) { const f32x4 sv = sp[q]; a += (sv[0] * w[4 * q] + sv[1] * w[4 * q + 1]) + (sv[2] * w[4 * q + 2] + sv[3] * w[4 * q + 3]); }
            a = wave_sum(a);
            if (C.lane == 0) BIAS[bi * nrows + n] = a;
        }
    }
}
__device__ __forceinline__ void final_norm_phase(const Ctx& C, const float* H, const float* gvec, float* out) {
    for (int m = C.gw; m < ML; m += C.NGW) {
        const f32x4* xr = (const f32x4*)(H + (size_t)m * DM) + C.lane;
        f32x4 v[4]; float s = 0.f;
#pragma unroll
        for (int j = 0; j < 4; ++j) { v[j] = xr[64 * j]; s += (v[j][0] * v[j][0] + v[j][1] * v[j][1]) + (v[j][2] * v[j][2] + v[j][3] * v[j][3]); }
        const float r = rsqrtf(wave_sum(s) * (1.f / 1024.f) + 1e-6f);
#pragma unroll
        for (int j = 0; j < 4; ++j) { const int c = 4 * (C.lane + 64 * j); const f32x4 g4 = *(const f32x4*)(gvec + c);
            *(f32x4*)(out + (size_t)m * DM + c) = v[j] * r * g4; }
    }
}

__device__ __forceinline__ void dump_phase(const Ctx& C, const bf16_t* a, const bf16_t* b, float* out) {
    const size_t n = (size_t)ML * 512;
    for (size_t i = (size_t)C.bid * 512 + C.tid; i < n; i += (size_t)C.G * 512) { out[i] = __uint_as_float((unsigned)a[i] << 16); out[n + i] = __uint_as_float((unsigned)b[i] << 16); }
}
#define GRID_SYNC() do { asm volatile("s_waitcnt vmcnt(0) lgkmcnt(0)" ::: "memory"); grid.sync(); __builtin_amdgcn_fence(__ATOMIC_ACQUIRE, "agent"); asm volatile("s_waitcnt vmcnt(0)" ::: "memory"); } while (0)
struct Args { const float* in[25]; float* out; unsigned char* ws; };

__device__ __forceinline__ void* ldptr(LAS unsigned long long* PT, int i) {
    unsigned off = 8u * (unsigned)i; asm volatile("" : "+s"(off));
    const unsigned long long v = *(LAS unsigned long long*)((LAS unsigned char*)PT + off);
    unsigned lo = __builtin_amdgcn_readfirstlane((unsigned)v), hi = __builtin_amdgcn_readfirstlane((unsigned)(v >> 32));
    asm volatile("" : "+s"(lo), "+s"(hi));
    return (void*)(((unsigned long long)hi << 32) | lo);
}
#define INP(i) ((const float*)ldptr(PT, i))
#define WSBASE() ((unsigned char*)ldptr(PT, 26))
#define OUTP ((float*)ldptr(PT, 25))
#define XIN INP(0)
#define cvec INP(1)
#define ctxin INP(2)
#define cctx INP(3)
#define wmod INP(4)
#define bmod INP(5)
#define normg INP(6)
#define f1w13 INP(7)
#define f1w2 INP(8)
#define win INP(9)
#define wfo INP(10)
#define LRE INP(11)
#define LIM INP(12)
#define LST INP(13)
#define BRE INP(14)
#define BIM INP(15)
#define CRE INP(16)
#define CIM INP(17)
#define SDD INP(18)
#define wglu INP(19)
#define wsso INP(20)
#define wout INP(21)
#define f2w13 INP(22)
#define f2w2 INP(23)
#define fing INP(24)
#define H ((float*)(WSBASE() + WS_H))
#define MOD ((float*)(WSBASE() + WS_MOD))
#define MODP ((float*)(WSBASE() + X_MODP))
#define HID ((bf16_t*)(WSBASE() + X_HID))
#define AN_FFN ((bf16_t*)(WSBASE() + X_AN_FFN))
#define AN_MIX ((bf16_t*)(WSBASE() + X_AN_MIX))
#define VT2 ((bf16_t*)(WSBASE() + X_VT2))
#define VT2C ((bf16_t*)(WSBASE() + X_VT2C))
#define SGF ((bf16_t*)(WSBASE() + X_SGF))
#define SGS ((bf16_t*)(WSBASE() + X_SGS))
#define UG ((bf16_t*)(WSBASE() + X_UG))
#define HIN ((bf16_t*)(WSBASE() + X_UG))
#define SB ((float*)(WSBASE() + X_S))
#define YS ((bf16_t*)(WSBASE() + X_YS))
#define ZG ((bf16_t*)(WSBASE() + X_ZG))
#define YF ((bf16_t*)(WSBASE() + X_YF))
#define YI ((bf16_t*)(WSBASE() + X_YI))
#define DFT ((bf16_t*)(WSBASE() + WS_DFT))
#define DFTC ((bf16_t*)(WSBASE() + WS_DFTC))
#define W13 ((bf16_t*)(WSBASE() + W_13))
#define W2 ((bf16_t*)(WSBASE() + W_2))
#define WIN ((bf16_t*)(WSBASE() + W_IN))
#define WFO ((bf16_t*)(WSBASE() + W_FO))
#define WGLU ((bf16_t*)(WSBASE() + W_GLU))
#define WSSO ((bf16_t*)(WSBASE() + W_SSO))
#define WOUT ((bf16_t*)(WSBASE() + W_OUT))
#define WSA ((bf16_t*)(WSBASE() + W_SA))
#define WSB ((bf16_t*)(WSBASE() + W_SB))
#define PART ((float*)(WSBASE() + WS_PART))
#define GSK(l_, k_) ((float*)(WSBASE() + WS_GS) + (size_t)((l_) * 3 + (k_)) * 9 * DM)
#define RVEC ((float*)(WSBASE() + WS_R))
#define ROWSQ ((float*)(WSBASE() + WS_ROWSQ))
#define BIASF ((float*)(WSBASE() + WS_BIASF))
#define BIASM ((float*)(WSBASE() + WS_BIASM))
__global__ void __launch_bounds__(512, 2) fwd_mega(Args args) {
    extern __shared__ __attribute__((aligned(16))) unsigned char lds_raw[];
    cg::grid_group grid = cg::this_grid();
    Ctx C; C.lds = (LAS unsigned char*)lds_raw; C.tid = threadIdx.x; C.lane = C.tid & 63; C.wave = __builtin_amdgcn_readfirstlane(C.tid >> 6);
    C.G = gridDim.x; C.bid = blockIdx.x; C.gw = C.bid * 8 + C.wave; C.NGW = C.G * 8;
    LAS unsigned long long* PT = (LAS unsigned long long*)(C.lds + 131072);
    if (threadIdx.x == 0) {
        PT[0] = (unsigned long long)args.in[0]; PT[1] = (unsigned long long)args.in[1]; PT[2] = (unsigned long long)args.in[2]; PT[3] = (unsigned long long)args.in[3]; PT[4] = (unsigned long long)args.in[4];
        PT[5] = (unsigned long long)args.in[5]; PT[6] = (unsigned long long)args.in[6]; PT[7] = (unsigned long long)args.in[7]; PT[8] = (unsigned long long)args.in[8]; PT[9] = (unsigned long long)args.in[9];
        PT[10] = (unsigned long long)args.in[10]; PT[11] = (unsigned long long)args.in[11]; PT[12] = (unsigned long long)args.in[12]; PT[13] = (unsigned long long)args.in[13]; PT[14] = (unsigned long long)args.in[14];
        PT[15] = (unsigned long long)args.in[15]; PT[16] = (unsigned long long)args.in[16]; PT[17] = (unsigned long long)args.in[17]; PT[18] = (unsigned long long)args.in[18]; PT[19] = (unsigned long long)args.in[19];
        PT[20] = (unsigned long long)args.in[20]; PT[21] = (unsigned long long)args.in[21]; PT[22] = (unsigned long long)args.in[22]; PT[23] = (unsigned long long)args.in[23]; PT[24] = (unsigned long long)args.in[24];
        PT[25] = (unsigned long long)args.out; PT[26] = (unsigned long long)args.ws;
    }
    __syncthreads();
    const int G = C.G, bid = C.bid;

    {
        const size_t nl = (size_t)ML * DM / 4, nc = (size_t)MC * DM / 4;
        for (size_t i = (size_t)bid * 512 + C.tid; i < nl + nc; i += (size_t)G * 512) ((f32x4*)H)[i] = i < nl ? ((const f32x4*)XIN)[i] : ((const f32x4*)ctxin)[i - nl];
        mod_partial_phase(C, cvec, cctx, wmod, MODP);
        dft_gen_phase(C, DFT, DFTC);
    }
    GRID_SYNC();
    mod_final_phase(C, bmod, normg, MODP, MOD, GSK(0, 0));

    for (int l = 0; l < DEPTH; ++l) {
#define MODl (MOD + (size_t)l * 9 * NMOD)
#define MKP(P) SsmP P; P.lre = LRE + l * 4096; P.lim = LIM + l * 4096; P.lst = LST + l * 64; P.bre = BRE + (size_t)l * 65536; P.bim = BIM + (size_t)l * 65536; \
        P.cre = CRE + (size_t)l * 65536; P.cim = CIM + (size_t)l * 65536; P.dd = SDD + l * 512;
#ifndef NO_PREP
        CTX_REFRESH(C);
        __syncthreads();
        transpose_mat(C, f1w13 + (size_t)l * 1024 * 5632, 1024, 5632, 0, 5632, W13, 1, 2816, 0);
        transpose_mat(C, f1w2 + (size_t)l * 2816 * 1024, 2816, 1024, 0, 1024, W2, 0, 0, 0);
        transpose_mat(C, win + (size_t)l * 1024 * 3072, 1024, 3072, 512, 2560, WIN, 0, 0, 1024);
        transpose_mat(C, wfo + (size_t)l * 512 * 1024, 512, 1024, 0, 1024, WFO, 0, 0, 0);
        transpose_mat(C, wglu + (size_t)l * 512 * 1024, 512, 1024, 0, 1024, WGLU, 1, 512, 0);
        transpose_mat(C, wsso + (size_t)l * 512 * 1024, 512, 1024, 0, 1024, WSSO, 0, 0, 0);
        transpose_mat(C, wout + (size_t)l * 1024 * 1024, 1024, 1024, 0, 1024, WOUT, 0, 0, 0);
        __syncthreads();
        CTX_REFRESH(C);
        fourier_weight_phase(C, win + (size_t)l * 1024 * 3072, WIN);
        CTX_REFRESH(C);
        { MKP(P) ssm_mats_phase(C, P, WSA, WSB); }
#endif
        GRID_SYNC(); CTX_REFRESH(C);

        for (int f = 0; f < 2; ++f) {
#ifndef NO_MIX
            if (f == 1) {
                fin_rows_phase(C, H, GSK(l, 1), AN_MIX, PART, 2, ROWSQ, RVEC, false);
                CTX_REFRESH(C);
                __syncthreads();
                transpose_mat(C, f2w13 + (size_t)l * 1024 * 5632, 1024, 5632, 0, 5632, W13, 1, 2816, 0);
                transpose_mat(C, f2w2 + (size_t)l * 2816 * 1024, 2816, 1024, 0, 1024, W2, 0, 0, 0);
                __syncthreads();
                GRID_SYNC(); CTX_REFRESH(C);
#if defined(DUMP) && DUMP == 8
                {
                    pg8::Sched S; S.init(AN_MIX, W13, MT / 256, 22, 1, 1024, 1024, 0, 0, G, bid);
                    EpiPair<0> E{HID, DFF, RVEC, BIASF}; pg8::gemm_phase(C.lds, C.wave, 1024, 1024, 1024, S, E);
                }
                GRID_SYNC(); CTX_REFRESH(C);
                dump_phase(C, HID, HID + (size_t)ML * 512, OUTP); return;
#endif
#if defined(DUMP) && DUMP == 5
                dump_phase(C, AN_MIX, AN_MIX + (size_t)ML * 512, OUTP); return;
#endif
#if defined(DUMP) && DUMP == 6
                { const size_t nw = (size_t)24 * MiB / 2, nall = (size_t)ML * DM;
                  for (size_t i = (size_t)C.bid * 512 + C.tid; i < nall; i += (size_t)C.G * 512) OUTP[i] = i < nw ? __uint_as_float((unsigned)WIN[i] << 16) : 0.f; }
                return;
#endif
#if (MIXSEL >> 0) & 1
                {
                    pg8::Sched S; S.init(WIN, AN_MIX, 4, MT / 256, 1, 1024, 1024, 0, 0, G, bid);
                    EpiInT E{VT2, VT2C, RVEC, BIASM}; pg8::gemm_phase(C.lds, C.wave, 1024, 1024, 1024, S, E);
                }
#endif
#if (MIXSEL >> 1) & 1
                {
                    pg8::Sched S; S.init(AN_MIX, WIN + (size_t)1024 * 1024, MT / 256, 2, 1, 1024, 1024, 0, 0, G, (bid + 32) % G);
                    EpiInU E{UG, RVEC, BIASM}; pg8::gemm_phase(C.lds, C.wave, 1024, 1024, 1024, S, E);
                }
                {
                    pg8::Sched S; S.init(AN_MIX, WIN + (size_t)1536 * 1024, MT / 256, 8, 1, 1024, 1024, 0, 0, G, (bid + 192) % G);
                    EpiInG E{SGF, SGS, RVEC, BIASM}; pg8::gemm_phase(C.lds, C.wave, 1024, 1024, 1024, S, E);
                }
#endif
                GRID_SYNC(); CTX_REFRESH(C);
#if defined(DUMP) && DUMP == 3
                dump_phase(C, SGF, SGS, OUTP); return;
#endif
#if defined(DUMP) && DUMP == 4
                dump_phase(C, VT2, VT2 + (size_t)ML * 512, OUTP); return;
#endif
#if (MIXSEL >> 2) & 1
                {
                    pg8::Sched S; S.init(DFT, VT2, 16, 2, 8, 8192, 8192, 0, (size_t)512 * 8192, G, bid);
                    EpiF2 E{YF, 0, 4096, 512}; pg8::gemm_phase(C.lds, C.wave, 8192, 8192, 8192, S, E);
                }
#endif
#if (MIXSEL >> 3) & 1
                {
                    pg8::Sched S; S.init(DFTC, VT2C, 1, 2, 8, 512, 512, 0, (size_t)512 * 512, G, bid);
                    EpiF2 E{YF, ML, 256, 512}; pg8::gemm_phase(C.lds, C.wave, 512, 512, 512, S, E);
                }
#endif
                GRID_SYNC(); CTX_REFRESH(C);
#if defined(DUMP) && DUMP == 1
                dump_phase(C, YF, SGS, OUTP); return;
#endif
#if (MIXSEL >> 4) & 1
                {
                    pg8::Sched S; S.init(UG, WSA, 9, 2, 32, 256, 256, (size_t)UROWS * 256, (size_t)512 * 256, G, bid);
                    EpiSsmA E{YI, SB}; pg8::gemm_phase(C.lds, C.wave, 256, 256, 256, S, E);
                }
#endif
#if (MIXSEL >> 5) & 1
                {
                    pg8::Sched S; S.init(YF, WFO, MT / 256, 4, 1, 512, 512, 0, 0, G, (bid + 64) % G);
                    EpiFo E{SGF}; pg8::gemm_phase(C.lds, C.wave, 512, 512, 512, S, E);
                }
#endif
                GRID_SYNC(); CTX_REFRESH(C);
                { MKP(P) ssm_scan_phase(C, P, SB, HIN); }
                GRID_SYNC(); CTX_REFRESH(C);
#if (MIXSEL >> 6) & 1
                {
                    pg8::Sched S; S.init(HIN, WSB, 9, 1, 32, 256, 256, (size_t)UROWS * 256, (size_t)256 * 256, G, bid);
                    EpiSsmB E{YI, YS}; pg8::gemm_phase(C.lds, C.wave, 256, 256, 256, S, E);
                }
#endif
                GRID_SYNC(); CTX_REFRESH(C);
#if defined(DUMP) && DUMP == 2
                dump_phase(C, YS, SGF, OUTP); return;
#endif
#if (MIXSEL >> 7) & 1
                {
                    pg8::Sched S; S.init(YS, WGLU, MT / 256, 4, 1, 512, 512, 0, 0, G, bid);
                    EpiPair<1> E{ZG, 512, nullptr, nullptr}; pg8::gemm_phase(C.lds, C.wave, 512, 512, 512, S, E);
                }
#endif
                GRID_SYNC(); CTX_REFRESH(C);
#if (MIXSEL >> 8) & 1
                {
                    pg8::Sched S; S.init(ZG, WSSO, MT / 256, 4, 1, 512, 512, 0, 0, G, bid);
                    EpiSso E{SGS, SGF}; pg8::gemm_phase(C.lds, C.wave, 512, 512, 512, S, E);
                }
#endif
                GRID_SYNC(); CTX_REFRESH(C);
#if (MIXSEL >> 9) & 1
                {
                    pg8::Sched S; S.init(SGS, WOUT, ML / 256, 4, 1, 1024, 1024, 0, 0, G, bid);
                    EpiRes<false, false> E{H, MODl + 5 * 1024, PART, GSK(l, 2), AN_FFN, ROWSQ}; pg8::gemm_phase(C.lds, C.wave, 1024, 1024, 1024, S, E);
                }
                {
                    pg8::Sched S; S.init(SGS + (size_t)ML * 1024, WOUT, MC / 256, 4, 4, 1024, 1024, 256, 256, G, (bid + G / 2) % G);
                    EpiRes<true, false> E{H, MODl + 5 * 1024, PART, nullptr, nullptr, nullptr}; pg8::gemm_phase(C.lds, C.wave, 256, 1024, 1024, S, E);
                }
#endif
                GRID_SYNC(); CTX_REFRESH(C);
            }
#endif
#ifndef NO_FFN
            const int kb = f == 0 ? 0 : 6;
            if (f == 0) { fin_rows_phase(C, H, GSK(l, 0), AN_FFN, PART, 2, ROWSQ, RVEC, l == 0);
                          bias_phase(C, W13, 5632, MODl, BIASF); bias_phase(C, WIN, 3584, MODl + 3 * 1024, BIASM); }
            else        { fin_rows_phase(C, H, GSK(l, 2), AN_FFN, PART, 4, ROWSQ, RVEC, false);
                          bias_phase(C, W13, 5632, MODl + 6 * 1024, BIASF); }
            GRID_SYNC(); CTX_REFRESH(C);
            {
                pg8::Sched S; S.init(AN_FFN, W13, MT / 256, 22, 1, 1024, 1024, 0, 0, G, bid);
                EpiPair<0> E{HID, DFF, RVEC, BIASF}; pg8::gemm_phase(C.lds, C.wave, 1024, 1024, 1024, S, E);
            }
            GRID_SYNC(); CTX_REFRESH(C);
            {
                pg8::Sched S; S.init(HID, W2, ML / 256, 4, 1, DFF, DFF, 0, 0, G, bid);
                EpiRes<false, true> E{H, MODl + (kb + 2) * 1024, PART, f == 0 ? GSK(l, 1) : GSK(l < 3 ? l + 1 : 3, 0), f == 0 ? AN_MIX : AN_FFN, ROWSQ}; pg8::gemm_phase(C.lds, C.wave, DFF, DFF, DFF, S, E);
            }
            {
                pg8::Sched S; S.init(HID + (size_t)ML * DFF, W2, MC / 256, 4, 2, DFF, DFF, 1408, 1408, G, (bid + G / 2) % G);
                EpiRes<true, true> E{H, MODl + (kb + 2) * 1024, PART, nullptr, nullptr, nullptr}; pg8::gemm_phase(C.lds, C.wave, 1408, DFF, DFF, S, E);
            }
            GRID_SYNC(); CTX_REFRESH(C);
#endif
        }
    }
    CTX_REFRESH(C);
    final_norm_phase(C, H, fing, OUTP);
}

extern "C" void kernel_launch(void* const* d_in, const int* in_sizes, int n_in, void* d_out, int out_size, void* d_ws, size_t ws_size, hipStream_t stream) {
    static int grid = 0;
    if (grid == 0) {
        if (n_in != 25 || ws_size < WS_END) { fprintf(stderr, "kernel_launch: bad n_in %d or ws_size %zu < %zu\n", n_in, ws_size, (size_t)WS_END); grid = -1; return; }
        int dev = 0, cus = 0, per_cu = 0;
        (void)hipGetDevice(&dev);
        (void)hipDeviceGetAttribute(&cus, hipDeviceAttributeMultiprocessorCount, dev);
        (void)hipFuncSetAttribute((const void*)fwd_mega, hipFuncAttributeMaxDynamicSharedMemorySize, LDS_BYTES);
        (void)hipOccupancyMaxActiveBlocksPerMultiprocessor(&per_cu, (const void*)fwd_mega, 512, LDS_BYTES);
        if (per_cu < 1) per_cu = 1;
        grid = cus * 1;
        if (grid < 160) { fprintf(stderr, "kernel_launch: needs >= 160 CUs (got %d)\n", grid); grid = -1; return; }
        fprintf(stderr, "kernel_launch: grid %d (cus %d, per_cu %d), ws %zu\n", grid, cus, per_cu, ws_size);
    }
    if (grid < 0) return;
    Args a{};
    for (int i = 0; i < 25; ++i) a.in[i] = (const float*)d_in[i];
    a.out = (float*)d_out; a.ws = (unsigned char*)d_ws;
    void* kargs[] = {&a};
    hipError_t e = hipLaunchCooperativeKernel((const void*)fwd_mega, dim3(grid), dim3(512), kargs, LDS_BYTES, stream);
    if (e != hipSuccess) fprintf(stderr, "kernel_launch: cooperative launch failed: %s\n", hipGetErrorString(e));
}
```

```cpp
#include <hip/hip_runtime.h>
#include <hip/hip_cooperative_groups.h>
#include <cstdio>
#include <cstdint>
namespace cg = cooperative_groups;
#ifndef MIXSEL
#define MIXSEL 0xffff
#endif

#define LAS __attribute__((address_space(3)))
typedef unsigned short bf16_t;
typedef short bf16x8 __attribute__((ext_vector_type(8)));
typedef float f32x4 __attribute__((ext_vector_type(4)));
typedef float f32x2 __attribute__((ext_vector_type(2)));
typedef unsigned u32x4 __attribute__((ext_vector_type(4)));
typedef unsigned u32x2 __attribute__((ext_vector_type(2)));

constexpr int DM = 1024, NB = 8, SEQ = 4096, CTX = 256, DEPTH = 4, DFF = 2816;
constexpr int ML = NB * SEQ, MC = NB * CTX, MT = ML + MC;
constexpr int NMOD = 9 * DM;
constexpr int UROWS = 2304;

constexpr size_t MiB = 1u << 20;
constexpr size_t WS_H = 0;
constexpr size_t WS_X = 136 * MiB;
constexpr size_t X_HID = WS_X;
constexpr size_t X_AN_FFN = WS_X + 276 * MiB;
constexpr size_t X_VT2 = WS_X;
constexpr size_t X_VT2C = WS_X + 64 * MiB;
constexpr size_t X_SGF = WS_X + 68 * MiB;
constexpr size_t X_SGS = WS_X + 136 * MiB;
constexpr size_t X_UG = WS_X + 204 * MiB;
constexpr size_t X_S = WS_X + 240 * MiB;
constexpr size_t X_AN_MIX = X_S;
constexpr size_t X_YS = X_S;
constexpr size_t X_ZG = X_S + 34 * MiB;
constexpr size_t X_YF = WS_X + 312 * MiB;
constexpr size_t X_YI = WS_X;
constexpr size_t X_MODP = WS_X;
constexpr size_t WS_DFT = 482 * MiB;
constexpr size_t WS_DFTC = 546 * MiB;
constexpr size_t WS_W = 547 * MiB;
constexpr size_t W_13 = WS_W;
constexpr size_t W_2 = WS_W + 11 * MiB;
constexpr size_t W_IN = WS_W + 17 * MiB;
constexpr size_t W_FO = WS_W + 24 * MiB;
constexpr size_t W_GLU = WS_W + 25 * MiB;
constexpr size_t W_SSO = WS_W + 26 * MiB;
constexpr size_t W_OUT = WS_W + 27 * MiB;
constexpr size_t W_SA = WS_W + 29 * MiB;
constexpr size_t W_SB = WS_W + 37 * MiB;
constexpr size_t WS_MOD = 588 * MiB;
constexpr size_t WS_PART = WS_X + 204 * MiB;
constexpr size_t WS_GS = WS_MOD + 1408 * 1024;
constexpr size_t WS_R = WS_MOD + 1856 * 1024;
constexpr size_t WS_ROWSQ = 590 * MiB;
constexpr size_t WS_BIASF = 592 * MiB + 256 * 1024;
constexpr size_t WS_BIASM = 592 * MiB + 512 * 1024;
constexpr size_t WS_CTL = 594 * MiB;
constexpr size_t CTL_BYTES = 16384;
constexpr size_t WS_END = 594 * MiB + 65536;

constexpr int LDS_BYTES = 139264;

__device__ __forceinline__ unsigned cvt_pk_bf16(float lo, float hi) { unsigned r; asm volatile("s_nop 1\n\tv_cvt_pk_bf16_f32 %0, %1, %2" : "=v"(r) : "v"(lo), "v"(hi)); return r; }
__device__ __forceinline__ float bf_lo(unsigned w) { return __uint_as_float(w << 16); }
__device__ __forceinline__ float bf_hi(unsigned w) { return __uint_as_float(w & 0xffff0000u); }
__device__ __forceinline__ float sigmoidf_(float x) { return __builtin_amdgcn_rcpf(1.f + __expf(-x)); }
__device__ __forceinline__ float siluf_(float x) { return x * sigmoidf_(x); }
__device__ __forceinline__ float gelu_tanh(float y) { const float u = 0.7978845608028654f * (y + 0.044715f * y * y * y); return y * sigmoidf_(2.f * u); }
__device__ __forceinline__ float wave_sum(float v) {
#pragma unroll
    for (int o = 1; o < 64; o <<= 1) v += __shfl_xor(v, o);
    return v;
}
__device__ __forceinline__ u32x4 pack8(const float (&r)[8]) { u32x4 w; w.x = cvt_pk_bf16(r[0], r[1]); w.y = cvt_pk_bf16(r[2], r[3]); w.z = cvt_pk_bf16(r[4], r[5]); w.w = cvt_pk_bf16(r[6], r[7]); return w; }
__device__ __forceinline__ void unpack8(const u32x4 w, float (&r)[8]) { r[0] = bf_lo(w.x); r[1] = bf_hi(w.x); r[2] = bf_lo(w.y); r[3] = bf_hi(w.y); r[4] = bf_lo(w.z); r[5] = bf_hi(w.z); r[6] = bf_lo(w.w); r[7] = bf_hi(w.w); }

namespace pg8 {
constexpr int BM = 256, BK = 64, HALF = 128, HTB = HALF * BK * 2, STAGE_BYTES = 8 * HTB, NXCD = 8, WGM = 8;
__host__ __device__ __forceinline__ int lds_byte(int r, int c) { const int st = (r >> 4) * 2 + (c >> 5), rr = r & 15, cc = c & 31, ob = rr * 64 + cc * 2; return st * 1024 + (ob ^ (((ob >> 9) & 1) << 5)); }
__host__ __device__ __forceinline__ void stage_rc(int b, int& R, int& C) { const int st = b / 1024, sb = b % 1024, swz = sb ^ (((sb >> 9) & 1) << 5); R = (st >> 1) * 16 + swz / 64; C = (st & 1) * 32 + (swz % 64) / 2; }
__host__ __device__ __forceinline__ int perm32(int rho) { const int n = rho >> 4, i = rho & 15; return 8 * (i >> 2) + 4 * n + (i & 3); }

struct Unit { int pm, pn, z; const char* a; const char* b; };

struct Sched {
    int nM, nN, nwg, G, c, per_z; const char* A; const char* B; size_t tA, tB, zA, zB;
    __device__ __forceinline__ void init(const void* A_, const void* B_, int nM_, int nN_, int nZ, size_t lda, size_t ldb, size_t zA_el, size_t zB_el, int G_, int c_) {
        A = (const char*)A_; B = (const char*)B_; nM = nM_; nN = nN_; per_z = nM_ * nN_; nwg = per_z * nZ; G = G_; c = c_;
        tA = (size_t)BM * lda * 2; tB = (size_t)BM * ldb * 2; zA = zA_el * 2; zB = zB_el * 2;
    }
    __device__ __forceinline__ bool next(int i, Unit& u) const {
        const long L = (long)i * G + c; if (L >= nwg) return false;
        int wgid = (int)L; { const int q = nwg / NXCD, r = nwg % NXCD, xcd = wgid % NXCD, off = wgid / NXCD; wgid = (xcd < r ? xcd * (q + 1) : r * (q + 1) + (xcd - r) * q) + off; }
        const int z = wgid / per_z, w = wgid % per_z;
        const int nig = WGM * nN, gid = w / nig, fm = gid * WGM, gsz = (nM - fm) < WGM ? (nM - fm) : WGM;
        u.pm = fm + ((w % nig) % gsz); u.pn = (w % nig) / gsz; u.z = z;
        u.a = A + (size_t)z * zA + (size_t)u.pm * tA; u.b = B + (size_t)z * zB + (size_t)u.pn * tB; return true;
    }
};

template <class Epi>
__device__ __forceinline__ void gemm_phase(LAS unsigned char* lds, const int wave_id, const int K_, const int lda_, const int ldb_, const Sched& S, const Epi& E) {
    int K = K_, lda = lda_, ldb = ldb_; asm volatile("" : "+s"(K), "+s"(lda), "+s"(ldb));
    const int lane = (int)__builtin_amdgcn_mbcnt_hi(~0u, __builtin_amdgcn_mbcnt_lo(~0u, 0u));
    int tid = (wave_id << 6) | lane; asm volatile("" : "+v"(tid));
    const int wid = wave_id, wr = wid >> 2, wc = wid & 3, fr = lane & 15, fq = lane >> 4;
    const int nt = K / BK;
    unsigned voffA[2], voffB[2];
#pragma unroll
    for (int i = 0; i < 2; ++i) { int R, C; stage_rc(tid * 16 + i * 8192, R, C); const int Rb = (R & ~31) + perm32(R & 31);
        voffA[i] = (unsigned)(R * lda + C) * 2u; voffB[i] = (unsigned)(Rb * ldb + C) * 2u; }
    const size_t kstep = (size_t)(BK * 2);
    const size_t hstepA = (size_t)HALF * lda * 2, hstepB = (size_t)HALF * ldb * 2;
    const unsigned ldsw = (unsigned)wid * 1024u;
    const int aoff = lds_byte(wr * 64 + fr, fq * 8), boff = lds_byte(wc * 32 + fr, fq * 8);
#define PG8_SA(b, h) (((b) * 2 + (h)) * HTB)
#define PG8_SB(b, h) ((4 + (b) * 2 + (h)) * HTB)
#define PG8_STAGE(bufoff, gbase, voff) do { const char* _g = (const char*)(gbase); asm volatile("" : "+s"(_g)); _Pragma("unroll") for (int _i = 0; _i < 2; ++_i) \
        __builtin_amdgcn_global_load_lds((const unsigned*)(_g + (voff)[_i]), (LAS unsigned*)(lds + (bufoff) + ldsw + _i * 8192), 16, 0, 0); } while (0)
#define PG8_LDA(dst, b, h) do { _Pragma("unroll") for (int m = 0; m < 4; ++m) _Pragma("unroll") for (int k = 0; k < 2; ++k) dst[m][k] = *(const LAS bf16x8*)(lds + PG8_SA(b, h) + aoff + m * 2048 + k * 1024); } while (0)
#define PG8_LDB(dst, b, h) do { _Pragma("unroll") for (int n = 0; n < 2; ++n) _Pragma("unroll") for (int k = 0; k < 2; ++k) dst[n][k] = *(const LAS bf16x8*)(lds + PG8_SB(b, h) + boff + n * 2048 + k * 1024); } while (0)
#define PG8_MMA(ai, bj, At, Bt) do { __builtin_amdgcn_s_setprio(1); _Pragma("unroll") for (int m = 0; m < 4; ++m) _Pragma("unroll") for (int n = 0; n < 2; ++n) _Pragma("unroll") for (int k = 0; k < 2; ++k) \
        acc[ai][bj][m][n] = __builtin_amdgcn_mfma_f32_16x16x32_bf16(Bt[n][k], At[m][k], acc[ai][bj][m][n], 0, 0, 0); __builtin_amdgcn_s_setprio(0); } while (0)
#define PG8_WAIT_V(n) asm volatile("s_waitcnt vmcnt(" #n ")" ::: "memory")
#define PG8_WAIT_L(n) asm volatile("s_waitcnt lgkmcnt(" #n ")" ::: "memory")
#define PG8_BAR __builtin_amdgcn_s_barrier()
#define PG8_SCHED __builtin_amdgcn_sched_barrier(0)
    Unit cur, nxt; int ui = 0;
    if (!S.next(0, cur)) return;
    f32x4 acc[2][2][4][2];
#pragma unroll
    for (int a = 0; a < 2; ++a)
#pragma unroll
        for (int b = 0; b < 2; ++b)
#pragma unroll
            for (int m = 0; m < 4; ++m)
#pragma unroll
                for (int n = 0; n < 2; ++n) acc[a][b][m][n] = (f32x4){0.f, 0.f, 0.f, 0.f};
    bf16x8 At[4][2], B0[2][2], B1[2][2];
    const char* cA = cur.a; const char* cB = cur.b;
    PG8_STAGE(PG8_SB(0, 0), cB, voffB); PG8_STAGE(PG8_SB(0, 1), cB + hstepB, voffB); PG8_STAGE(PG8_SA(0, 0), cA, voffA); PG8_STAGE(PG8_SA(0, 1), cA + hstepA, voffA);
    if (wr == 1) PG8_BAR;
    PG8_WAIT_V(2); PG8_BAR;
    PG8_STAGE(PG8_SB(1, 0), cB + kstep, voffB); PG8_STAGE(PG8_SA(1, 0), cA + kstep, voffA); PG8_STAGE(PG8_SB(1, 1), cB + hstepB + kstep, voffB);
    PG8_WAIT_V(6); PG8_BAR;
    for (;;) {
        const bool has_next = S.next(ui + 1, nxt);
        const char* nA = has_next ? nxt.a : cA; const char* nB = has_next ? nxt.b : cB;
        for (int t = 0; t < nt; t += 2) {
            const bool last = (t == nt - 2);
            const char* a1 = cA + (size_t)(t + 1) * kstep;
            const char* a2 = last ? nA : cA + (size_t)(t + 2) * kstep; const char* b2 = last ? nB : cB + (size_t)(t + 2) * kstep;
            const char* a3 = a2 + kstep; const char* b3 = b2 + kstep;
            PG8_LDB(B0, 0, 0); PG8_LDB(B1, 0, 1); PG8_SCHED; PG8_LDA(At, 0, 0); PG8_STAGE(PG8_SA(1, 1), a1 + hstepA, voffA);
            PG8_WAIT_V(8); PG8_WAIT_L(0); PG8_BAR; PG8_MMA(0, 0, At, B0); PG8_MMA(0, 1, At, B1); PG8_BAR; PG8_SCHED;
            PG8_LDA(At, 0, 1); PG8_STAGE(PG8_SB(0, 0), b2, voffB); PG8_STAGE(PG8_SB(0, 1), b2 + hstepB, voffB); PG8_STAGE(PG8_SA(0, 0), a2, voffA);
            PG8_WAIT_V(8); PG8_WAIT_L(0); PG8_BAR; PG8_MMA(1, 0, At, B0); PG8_MMA(1, 1, At, B1); PG8_BAR; PG8_SCHED;
            PG8_LDB(B0, 1, 0); PG8_LDB(B1, 1, 1); PG8_SCHED; PG8_LDA(At, 1, 0); PG8_STAGE(PG8_SA(0, 1), a2 + hstepA, voffA);
            PG8_WAIT_V(8); PG8_WAIT_L(0); PG8_BAR; PG8_MMA(0, 0, At, B0); PG8_MMA(0, 1, At, B1); PG8_BAR; PG8_SCHED;
            PG8_LDA(At, 1, 1); PG8_STAGE(PG8_SB(1, 0), b3, voffB); PG8_STAGE(PG8_SB(1, 1), b3 + hstepB, voffB); PG8_STAGE(PG8_SA(1, 0), a3, voffA);
            PG8_WAIT_V(8); PG8_WAIT_L(0); PG8_BAR; PG8_MMA(1, 0, At, B0); PG8_MMA(1, 1, At, B1); PG8_BAR; PG8_SCHED;
        }
        if (wr == 0) PG8_BAR;
        { int fr2 = fr, fq2 = fq; asm volatile("" : "+v"(fr2), "+v"(fq2)); E(acc, cur, wr, wc, fr2, fq2); }
        if (!has_next) break;
#pragma unroll
        for (int a = 0; a < 2; ++a)
#pragma unroll
            for (int b = 0; b < 2; ++b)
#pragma unroll
                for (int m = 0; m < 4; ++m)
#pragma unroll
                    for (int n = 0; n < 2; ++n) acc[a][b][m][n] = (f32x4){0.f, 0.f, 0.f, 0.f};
        cur = nxt; cA = nA; cB = nB; ++ui;
        if (wr == 1) PG8_BAR;
    }
    PG8_WAIT_V(0);
    PG8_BAR;
#undef PG8_SA
#undef PG8_SB
#undef PG8_STAGE
#undef PG8_LDA
#undef PG8_LDB
#undef PG8_MMA
#undef PG8_WAIT_V
#undef PG8_WAIT_L
#undef PG8_BAR
#undef PG8_SCHED
}
}
using pg8::Unit;
typedef f32x4 AccT[2][2][4][2];

#define EPI_ROWS_BEGIN _Pragma("unroll") for (int ai = 0; ai < 2; ++ai) _Pragma("unroll") for (int m = 0; m < 4; ++m) { const int row = u.pm * 256 + ai * 128 + wr * 64 + m * 16 + fr;
#define EPI_ROWS_END if (m & 1) asm volatile("" ::: "memory"); }
#define EPI_LOAD_R(R) float rr8[2][4]; _Pragma("unroll") for (int ai = 0; ai < 2; ++ai) _Pragma("unroll") for (int m = 0; m < 4; ++m) rr8[ai][m] = (R)[u.pm * 256 + ai * 128 + wr * 64 + m * 16 + fr];
#define ACC8(dst, ai, bj, m) { const f32x4 _a = acc[ai][bj][m][0], _b = acc[ai][bj][m][1]; dst[0] = _a[0]; dst[1] = _a[1]; dst[2] = _a[2]; dst[3] = _a[3]; dst[4] = _b[0]; dst[5] = _b[1]; dst[6] = _b[2]; dst[7] = _b[3]; }

template <int MODE  > struct EpiPair {
    bf16_t* O; int ldo; const float* R; const float* BIAS;
    __device__ __forceinline__ void operator()(const AccT& acc, const Unit& u, int wr, int wc, int fr, int fq) const {
        const int col = u.pn * 128 + wc * 32 + 8 * fq;
        f32x4 ba0, ba1, bb0, bb1; float rr8[2][4];
        if (MODE == 0) {
            const int rt = u.pm * 256; const float* bp = BIAS + (rt < ML ? (rt >> 12) : 8) * 5632 + u.pn * 256 + wc * 32 + 8 * fq;
            ba0 = *(const f32x4*)bp; ba1 = *(const f32x4*)(bp + 4); bb0 = *(const f32x4*)(bp + 128); bb1 = *(const f32x4*)(bp + 132);
#pragma unroll
            for (int ai = 0; ai < 2; ++ai)
#pragma unroll
                for (int m = 0; m < 4; ++m) rr8[ai][m] = R[rt + ai * 128 + wr * 64 + m * 16 + fr];
        }
        EPI_ROWS_BEGIN
            float a[8], b[8], r[8]; ACC8(a, ai, 0, m); ACC8(b, ai, 1, m);
            if (MODE == 0) {
                const float rr = rr8[ai][m];
#pragma unroll
                for (int j = 0; j < 4; ++j) { a[j] = rr * a[j] + ba0[j]; a[4 + j] = rr * a[4 + j] + ba1[j]; b[j] = rr * b[j] + bb0[j]; b[4 + j] = rr * b[4 + j] + bb1[j]; }
            }
#pragma unroll
            for (int j = 0; j < 8; ++j) r[j] = MODE == 0 ? siluf_(a[j]) * b[j] : a[j] * sigmoidf_(b[j]);
            *(u32x4*)(O + (size_t)row * ldo + col) = pack8(r);
        EPI_ROWS_END
    }
};
template <bool SLICE, bool HALFSTEP> struct EpiRes {
    float* H; const float* gate; float* PART; const float* GS; bf16_t* AN; float* ROWSQ;
    __device__ __forceinline__ void operator()(const AccT& acc, const Unit& u, int wr, int wc, int fr, int fq) const {
        constexpr float sc = HALFSTEP ? 0.5f : 1.0f; constexpr int row0 = SLICE ? ML : 0;
        const int rt = row0 + u.pm * 256, bi = rt < ML ? (rt >> 12) : 8;
        f32x4 gq[2][2], sq[2][2];
#pragma unroll
        for (int bj = 0; bj < 2; ++bj) { const int col = u.pn * 256 + bj * 128 + wc * 32 + 8 * fq;
            const float* gp = gate + bi * NMOD + col; gq[bj][0] = *(const f32x4*)gp * sc; gq[bj][1] = *(const f32x4*)(gp + 4) * sc;
            if (!SLICE) { const float* gsp = GS + bi * DM + col; sq[bj][0] = *(const f32x4*)gsp; sq[bj][1] = *(const f32x4*)(gsp + 4); } }
        EPI_ROWS_BEGIN
            const int grow = row0 + row;
            float ss = 0.f;
#pragma unroll
            for (int bj = 0; bj < 2; ++bj) {
                const int col = u.pn * 256 + bj * 128 + wc * 32 + 8 * fq;
                float* p = H + (size_t)grow * DM + col;
                const f32x4 d0 = gq[bj][0] * acc[ai][bj][m][0], d1 = gq[bj][1] * acc[ai][bj][m][1];
                if (SLICE) {
                    float* pp = PART + ((size_t)u.z * MC + (grow - ML)) * DM + col;
                    *(f32x4*)pp = d0; *(f32x4*)(pp + 4) = d1;
                } else {
                    f32x4 h0 = *(const f32x4*)p, h1 = *(const f32x4*)(p + 4);
                    h0 += d0; h1 += d1;
                    *(f32x4*)p = h0; *(f32x4*)(p + 4) = h1;
                    ss += (h0[0] * h0[0] + h0[1] * h0[1]) + (h0[2] * h0[2] + h0[3] * h0[3]) + (h1[0] * h1[0] + h1[1] * h1[1]) + (h1[2] * h1[2] + h1[3] * h1[3]);
                    h0 *= sq[bj][0]; h1 *= sq[bj][1];
                    float r[8] = {h0[0], h0[1], h0[2], h0[3], h1[0], h1[1], h1[2], h1[3]};
                    *(u32x4*)(AN + (size_t)grow * DM + col) = pack8(r);
                }
            }
            if (!SLICE) { ss += __shfl_xor(ss, 16); ss += __shfl_xor(ss, 32); if (fq == 0) ROWSQ[(size_t)grow * 16 + u.pn * 4 + wc] = ss; }
        EPI_ROWS_END
    }
};
struct EpiInT {
    bf16_t* VT2; bf16_t* VT2C; const float* R; const float* BIAS;
    __device__ __forceinline__ void operator()(const AccT& acc, const Unit& u, int wr, int wc, int fr, int fq) const {
        const int mt0 = u.pn * 256; const float* bb = BIAS + (mt0 < ML ? (mt0 >> 12) : 8) * 3584;
        f32x4 rr[2][2];
#pragma unroll
        for (int bj = 0; bj < 2; ++bj) { const float* rp = R + mt0 + bj * 128 + wc * 32 + 8 * fq; rr[bj][0] = *(const f32x4*)rp; rr[bj][1] = *(const f32x4*)(rp + 4); }
        EPI_LOAD_R(bb)
        EPI_ROWS_BEGIN
            const int grp = row >> 8, part = (row >> 7) & 1, ch = grp * 128 + (row & 127); const float bv = rr8[ai][m];
#pragma unroll
            for (int bj = 0; bj < 2; ++bj) {
                const int m0 = mt0 + bj * 128 + wc * 32 + 8 * fq;
                const f32x4 v0 = acc[ai][bj][m][0] * rr[bj][0] + bv, v1 = acc[ai][bj][m][1] * rr[bj][1] + bv;
                float r[8] = {v0[0], v0[1], v0[2], v0[3], v1[0], v1[1], v1[2], v1[3]};
                bf16_t* dst;
                if (m0 < ML) { const int b = m0 >> 12, t = m0 & 4095; dst = VT2 + ((size_t)(b * 512 + ch) * 8192 + part * 4096 + t); }
                else { const int mm = m0 - ML, b = mm >> 8, t = mm & 255; dst = VT2C + ((size_t)(b * 512 + ch) * 512 + part * 256 + t); }
                *(u32x4*)dst = pack8(r);
            }
        EPI_ROWS_END
    }
};
struct EpiInU {
    bf16_t* UG; const float* R; const float* BIAS;
    __device__ __forceinline__ void operator()(const AccT& acc, const Unit& u, int wr, int wc, int fr, int fq) const {
        const int rt = u.pm * 256; const float* bb = BIAS + (rt < ML ? (rt >> 12) : 8) * 3584 + 1024;
        f32x4 bq[2][2];
#pragma unroll
        for (int bj = 0; bj < 2; ++bj) { const int c = u.pn * 256 + bj * 128 + wc * 32 + 8 * fq; bq[bj][0] = *(const f32x4*)(bb + c); bq[bj][1] = *(const f32x4*)(bb + c + 4); }
        EPI_LOAD_R(R)
        EPI_ROWS_BEGIN
            int urow, ii;
            if (row < ML) { const int b = row >> 12, t = row & 4095; urow = b * 256 + (t >> 4); ii = t & 15; }
            else { const int mm = row - ML, b = mm >> 8, t = mm & 255; urow = 2048 + b * 16 + (t >> 4); ii = t & 15; }
            const float rr = rr8[ai][m];
#pragma unroll
            for (int bj = 0; bj < 2; ++bj) {
                const int c = u.pn * 256 + bj * 128 + wc * 32 + 8 * fq, g = c >> 4, h0 = c & 15;
                const f32x4 v0 = acc[ai][bj][m][0] * rr + bq[bj][0], v1 = acc[ai][bj][m][1] * rr + bq[bj][1];
                float r[8] = {v0[0], v0[1], v0[2], v0[3], v1[0], v1[1], v1[2], v1[3]};
                *(u32x4*)(UG + ((size_t)(g * UROWS + urow) * 256 + ii * 16 + h0)) = pack8(r);
            }
        EPI_ROWS_END
    }
};
struct EpiInG {
    bf16_t* SGF; bf16_t* SGS; const float* R; const float* BIAS;
    __device__ __forceinline__ void operator()(const AccT& acc, const Unit& u, int wr, int wc, int fr, int fq) const {
        bf16_t* base = u.pn < 4 ? SGF : SGS; const int c0 = (u.pn & 3) * 256 + wc * 32 + 8 * fq, cb = 1536 + u.pn * 256 + wc * 32 + 8 * fq;
        const int rt = u.pm * 256; const float* bb = BIAS + (rt < ML ? (rt >> 12) : 8) * 3584 + cb;
        f32x4 bq[2][2];
#pragma unroll
        for (int bj = 0; bj < 2; ++bj) { bq[bj][0] = *(const f32x4*)(bb + bj * 128); bq[bj][1] = *(const f32x4*)(bb + bj * 128 + 4); }
        EPI_LOAD_R(R)
        EPI_ROWS_BEGIN
            const float rr = rr8[ai][m];
#pragma unroll
            for (int bj = 0; bj < 2; ++bj) {
                const f32x4 v0 = acc[ai][bj][m][0] * rr + bq[bj][0], v1 = acc[ai][bj][m][1] * rr + bq[bj][1];
                float r[8] = {v0[0], v0[1], v0[2], v0[3], v1[0], v1[1], v1[2], v1[3]};
#pragma unroll
                for (int j = 0; j < 8; ++j) r[j] = sigmoidf_(r[j]);
                *(u32x4*)(base + (size_t)row * DM + c0 + bj * 128) = pack8(r);
            }
        EPI_ROWS_END
    }
};
struct EpiF2 {
    bf16_t* O; int rbase, zrows, ldo;
    __device__ __forceinline__ void operator()(const AccT& acc, const Unit& u, int wr, int wc, int fr, int fq) const {
        EPI_ROWS_BEGIN
            const size_t orow = (size_t)(rbase + u.z * zrows + row);
#pragma unroll
            for (int bj = 0; bj < 2; ++bj) { float r[8]; ACC8(r, ai, bj, m); *(u32x4*)(O + orow * ldo + u.pn * 256 + bj * 128 + wc * 32 + 8 * fq) = pack8(r); }
        EPI_ROWS_END
    }
};
struct EpiSsmA {
    bf16_t* YI; float* S;
    __device__ __forceinline__ void operator()(const AccT& acc, const Unit& u, int wr, int wc, int fr, int fq) const {
        EPI_ROWS_BEGIN
            const size_t base = ((size_t)u.z * UROWS + row) * 256;
#pragma unroll
            for (int bj = 0; bj < 2; ++bj) {
                const int col = bj * 128 + wc * 32 + 8 * fq;
                if (u.pn == 0) { float r[8]; ACC8(r, ai, bj, m); *(u32x4*)(YI + base + col) = pack8(r); }
                else { *(f32x4*)(S + base + col) = acc[ai][bj][m][0]; *(f32x4*)(S + base + col + 4) = acc[ai][bj][m][1]; }
            }
        EPI_ROWS_END
    }
};
struct EpiSsmB {
    const bf16_t* YI; bf16_t* YS;
    __device__ __forceinline__ void operator()(const AccT& acc, const Unit& u, int wr, int wc, int fr, int fq) const {
        EPI_ROWS_BEGIN
            int tok0;
            if (row < 2048) tok0 = (row >> 8) * 4096 + (row & 255) * 16;
            else { const int rr = row - 2048; tok0 = ML + (rr >> 4) * 256 + (rr & 15) * 16; }
            if (row < 2176) {
                const size_t base = ((size_t)u.z * UROWS + row) * 256;
#pragma unroll
                for (int bj = 0; bj < 2; ++bj) {
                    const int col = bj * 128 + wc * 32 + 8 * fq, j = col >> 4, h0 = col & 15;
                    float r[8], yi[8]; ACC8(r, ai, bj, m); unpack8(*(const u32x4*)(YI + base + col), yi);
#pragma unroll
                    for (int q = 0; q < 8; ++q) r[q] = gelu_tanh(r[q] + yi[q]);
                    *(u32x4*)(YS + (size_t)(tok0 + j) * 512 + u.z * 16 + h0) = pack8(r);
                }
            }
        EPI_ROWS_END
    }
};
struct EpiFo {
    bf16_t* SGF;
    __device__ __forceinline__ void operator()(const AccT& acc, const Unit& u, int wr, int wc, int fr, int fq) const {
        EPI_ROWS_BEGIN
#pragma unroll
            for (int bj = 0; bj < 2; ++bj) {
                bf16_t* p = SGF + (size_t)row * DM + u.pn * 256 + bj * 128 + wc * 32 + 8 * fq;
                float r[8], g[8]; ACC8(r, ai, bj, m); unpack8(*(const u32x4*)p, g);
#pragma unroll
                for (int q = 0; q < 8; ++q) r[q] *= g[q];
                *(u32x4*)p = pack8(r);
            }
        EPI_ROWS_END
    }
};
struct EpiSso {
    bf16_t* SGS; const bf16_t* MG1;
    __device__ __forceinline__ void operator()(const AccT& acc, const Unit& u, int wr, int wc, int fr, int fq) const {
        EPI_ROWS_BEGIN
#pragma unroll
            for (int bj = 0; bj < 2; ++bj) {
                const size_t off = (size_t)row * DM + u.pn * 256 + bj * 128 + wc * 32 + 8 * fq;
                float r[8], g[8], f[8]; ACC8(r, ai, bj, m); unpack8(*(const u32x4*)(SGS + off), g); unpack8(*(const u32x4*)(MG1 + off), f);
#pragma unroll
                for (int q = 0; q < 8; ++q) r[q] = f[q] + g[q] * r[q];
                *(u32x4*)(SGS + off) = pack8(r);
            }
        EPI_ROWS_END
    }
};

struct Ctx { LAS unsigned char* lds; int tid, lane, wave, G, bid, gw, NGW; };
#define CTX_REFRESH(C) do { int _t = ((C).wave << 6) | (int)__builtin_amdgcn_mbcnt_hi(~0u, __builtin_amdgcn_mbcnt_lo(~0u, 0u)); asm volatile("" : "+v"(_t)); (C).tid = _t; (C).lane = _t & 63; int _g = (C).gw; asm volatile("" : "+s"(_g)); (C).gw = _g; } while (0)

__device__ __forceinline__ void transpose_item(const Ctx& C, const float* W, int K, int ldw, int n0, int ncols, bf16_t* WT, int mode, int half, int row_off, int item) {
    LAS float* scr = (LAS float*)(C.lds + C.wave * 16384);
    const int nblk = ncols / 32, kb = item / nblk, nb = item % nblk, k0 = 64 * kb, nr0 = 32 * nb, lane = C.lane;
    int r0;
    if (mode == 0) r0 = row_off + nr0;
    else { const int hsel = nr0 >= half ? 1 : 0, j = nr0 - hsel * half; r0 = (j >> 7) * 256 + hsel * 128 + (j & 127); }
#pragma unroll 8
    for (int i = 0; i < 32; ++i) { const int kk = 2 * i + (lane >> 5); scr[kk * 33 + (lane & 31)] = W[(size_t)(k0 + kk) * ldw + n0 + nr0 + (lane & 31)]; }
    asm volatile("s_waitcnt lgkmcnt(0)" ::: "memory");
    const int c = lane & 7;
#pragma unroll
    for (int j = 0; j < 4; ++j) { const int n = (lane >> 3) + 8 * j; const LAS float* s = scr + (8 * c) * 33 + n;
        u32x4 o; o.x = cvt_pk_bf16(s[0 * 33], s[1 * 33]); o.y = cvt_pk_bf16(s[2 * 33], s[3 * 33]); o.z = cvt_pk_bf16(s[4 * 33], s[5 * 33]); o.w = cvt_pk_bf16(s[6 * 33], s[7 * 33]);
        *(u32x4*)(WT + (size_t)(r0 + n) * K + k0 + 8 * c) = o; }
    asm volatile("s_waitcnt lgkmcnt(0)" ::: "memory");
}
__device__ __forceinline__ void transpose_mat(const Ctx& C, const float* W, int K, int ldw, int n0, int ncols, bf16_t* WT, int mode, int half, int row_off) {
    const int items = (K / 64) * (ncols / 32);
    for (int it = C.gw; it < items; it += C.NGW) transpose_item(C, W, K, ldw, n0, ncols, WT, mode, half, row_off, it);
}

__device__ __forceinline__ void fourier_weight_phase(const Ctx& C, const float* Win  , bf16_t* WT) {
    LAS float* Wl = (LAS float*)C.lds; LAS float* ct = Wl + 16 * 129; LAS float* st = ct + 128;
    for (int it = C.bid; it < 256; it += C.G) {
        const int grp = it >> 6, k0 = (it & 63) * 16;
        for (int e = C.tid; e < 16 * 128; e += 512) { const int k = e >> 7, c = e & 127; Wl[k * 129 + c] = Win[(size_t)(k0 + k) * 3072 + grp * 128 + c]; }
        if (C.tid < 128) { float sn, cs; sincosf(6.283185307179586f * (float)C.tid * (1.f / 128.f), &sn, &cs); ct[C.tid] = cs; st[C.tid] = sn; }
        __syncthreads();
        const int k = C.tid & 15, jj = C.tid >> 4;
        float a[8];
#pragma unroll
        for (int i = 0; i < 8; ++i) a[i] = 0.f;
        const int part = jj >> 4, j0 = (jj & 15) * 8; const LAS float* tb = part ? st : ct;
        for (int c = 0; c < 128; ++c) { const float w = Wl[k * 129 + c];
#pragma unroll
            for (int i = 0; i < 8; ++i) a[i] += w * tb[(c * (j0 + i)) & 127]; }
#pragma unroll
        for (int i = 0; i < 8; ++i) { const unsigned pk = cvt_pk_bf16(a[i] * 0.08838834764831845f, 0.f);
            WT[(size_t)(grp * 256 + jj * 8 + i) * 1024 + k0 + k] = (bf16_t)(pk & 0xffffu); }
        __syncthreads();
    }
}

struct SsmP { const float *lre, *lim, *lst, *bre, *bim, *cre, *cim, *dd; };
__device__ __forceinline__ void ssm_mats_phase(const Ctx& C, const SsmP& P, bf16_t* Wa, bf16_t* Wb) {
    LAS float* LP = (LAS float*)C.lds;
    LAS float* BB = LP + 2 * 17 * 64 * 2;
    LAS float* CC = BB + 2 * 64 * 16 * 2;
    LAS float* KK = CC + 2 * 16 * 64 * 2;
    const int tid = C.tid;
    for (int g = (C.bid + C.G - 128) % C.G; g < 32; g += C.G) {
        if (tid < 128) {
            const int d = tid >> 6, p = tid & 63;
            const float dt = expf(P.lst[d * 32 + g]); const float lr = P.lre[(d * 32 + g) * 64 + p], li = P.lim[(d * 32 + g) * 64 + p];
            float l1r = 0.f, l1i = 0.f;
            for (int t = 0; t <= 16; ++t) { const float mag = expf(lr * dt * (float)t); float s, c; sincosf(li * dt * (float)t, &s, &c);
                LP[((d * 17 + t) * 64 + p) * 2] = mag * c; LP[((d * 17 + t) * 64 + p) * 2 + 1] = mag * s; if (t == 1) { l1r = mag * c; l1i = mag * s; } }
            const float nr = l1r - 1.f, ni = l1i, den = lr * lr + li * li;
            const float kr = (nr * lr + ni * li) / den, ki = (ni * lr - nr * li) / den;
            for (int h = 0; h < 16; ++h) { const size_t bi_ = ((size_t)(d * 32 + g) * 64 + p) * 16 + h; const float br = P.bre[bi_], bi = P.bim[bi_];
                BB[((d * 64 + p) * 16 + h) * 2] = kr * br - ki * bi; BB[((d * 64 + p) * 16 + h) * 2 + 1] = kr * bi + ki * br; }
        }
        for (int e = tid; e < 2048; e += 512) { const int d = e >> 10, h = (e >> 6) & 15, p = e & 63; const size_t ci_ = ((size_t)(d * 32 + g) * 16 + h) * 64 + p;
            CC[((d * 64 + p) * 16 + h) * 2] = P.cre[ci_]; CC[((d * 64 + p) * 16 + h) * 2 + 1] = P.cim[ci_]; }
        __syncthreads();
        {
            const int d = tid >> 8, t = (tid >> 4) & 15, h = tid & 15;
            float a[16];
#pragma unroll
            for (int q = 0; q < 16; ++q) a[q] = 0.f;
            for (int p = 0; p < 64; ++p) {
                const float cr = CC[((d * 64 + p) * 16 + h) * 2], ci = CC[((d * 64 + p) * 16 + h) * 2 + 1];
                const float Lr = LP[((d * 17 + t) * 64 + p) * 2], Li = LP[((d * 17 + t) * 64 + p) * 2 + 1];
                const float gr = cr * Lr - ci * Li, gi = cr * Li + ci * Lr;
#pragma unroll
                for (int q = 0; q < 16; ++q) a[q] += gr * BB[((d * 64 + p) * 16 + q) * 2] - gi * BB[((d * 64 + p) * 16 + q) * 2 + 1];
            }
#pragma unroll
            for (int q = 0; q < 16; ++q) KK[((d * 16 + t) * 16 + h) * 16 + q] = a[q];
        }
        __syncthreads();
        bf16_t* wa = Wa + (size_t)g * 512 * 256;
        for (int v = tid; v < 512 * 32; v += 512) {
            const int n = v >> 5, kv = (v & 31) * 8, i = kv >> 4, hp0 = kv & 15;
            float r[8];
            if (n < 256) {
                const int j = n >> 4, h = n & 15;
#pragma unroll
                for (int q = 0; q < 8; ++q) { const int hp = hp0 + q; float x = 0.f;
                    if (j >= i) x += KK[((0 * 16 + (j - i)) * 16 + h) * 16 + hp];
                    if (i >= j) x += KK[((1 * 16 + (i - j)) * 16 + h) * 16 + hp];
                    if (i == j && h == hp) x += P.dd[g * 16 + h];
                    r[q] = x; }
            } else {
                const int qn = n - 256, d = qn >> 7, ri = (qn >> 6) & 1, p = qn & 63, t = d == 0 ? 15 - i : i;
                const float Lr = LP[((d * 17 + t) * 64 + p) * 2], Li = LP[((d * 17 + t) * 64 + p) * 2 + 1];
#pragma unroll
                for (int q = 0; q < 8; ++q) { const int hp = hp0 + q; const float br = BB[((d * 64 + p) * 16 + hp) * 2], bi = BB[((d * 64 + p) * 16 + hp) * 2 + 1];
                    r[q] = ri ? (Lr * bi + Li * br) : (Lr * br - Li * bi); }
            }
            *(u32x4*)(wa + (size_t)n * 256 + kv) = pack8(r);
        }
        bf16_t* wb = Wb + (size_t)g * 256 * 256;
        for (int v = tid; v < 256 * 32; v += 512) {
            const int n = v >> 5, kv = (v & 31) * 8, j = n >> 4, h = n & 15, d = kv >> 7, ri = (kv >> 6) & 1, p0 = kv & 63, e = d == 0 ? j + 1 : 16 - j;
            float r[8];
#pragma unroll
            for (int q = 0; q < 8; ++q) { const int p = p0 + q;
                const float cr = CC[((d * 64 + p) * 16 + h) * 2], ci = CC[((d * 64 + p) * 16 + h) * 2 + 1];
                const float Lr = LP[((d * 17 + e) * 64 + p) * 2], Li = LP[((d * 17 + e) * 64 + p) * 2 + 1];
                r[q] = ri ? -(cr * Li + ci * Lr) : (cr * Lr - ci * Li); }
            *(u32x4*)(wb + (size_t)n * 256 + kv) = pack8(r);
        }
        __syncthreads();
    }
}

__device__ __forceinline__ void ssm_scan_phase(const Ctx& C, const SsmP& P, const float* S, bf16_t* Hin) {
    for (int it = C.bid; it < 256; it += C.G) {
        const int g = it >> 3, b = it & 7;
        if (C.tid < 128) {
            const int d = C.tid >> 6, p = C.tid & 63;
            const float dt = expf(P.lst[d * 32 + g]); const float lr = P.lre[(d * 32 + g) * 64 + p], li = P.lim[(d * 32 + g) * 64 + p];
            const float mag = expf(lr * dt * 16.f); float sn, cs; sincosf(li * dt * 16.f, &sn, &cs);
            const float Ar = mag * cs, Ai = mag * sn;
            float hr = 0.f, hi = 0.f;
            const float* Sg = S + (size_t)g * UROWS * 256 + d * 128 + p; bf16_t* Hg = Hin + (size_t)g * UROWS * 256 + d * 128 + p;
            for (int s0 = 0; s0 < 272; s0 += 16) {
                float sr[16], si[16];
                int rowb, dir;
                if (s0 == 0) { rowb = 2048 + b * 16 + (d ? 15 : 0); dir = d ? -1 : 1; }
                else { rowb = b * 256 + (d ? 271 - s0 : s0 - 16); dir = d ? -1 : 1; }
#pragma unroll
                for (int q = 0; q < 16; ++q) { const size_t o = (size_t)(rowb + dir * q) * 256; sr[q] = Sg[o]; si[q] = Sg[o + 64]; }
#pragma unroll
                for (int q = 0; q < 16; ++q) { const size_t o = (size_t)(rowb + dir * q) * 256;
                    const unsigned pk = cvt_pk_bf16(hr, hi); Hg[o] = (bf16_t)(pk & 0xffffu); Hg[o + 64] = (bf16_t)(pk >> 16);
                    const float nr = Ar * hr - Ai * hi + sr[q], ni = Ar * hi + Ai * hr + si[q]; hr = nr; hi = ni; }
            }
        }
    }
}

__device__ __forceinline__ void mod_partial_phase(const Ctx& C, const float* cvec, const float* cctx, const float* wmod, float* MODP) {
    LAS float* cvs = (LAS float*)C.lds;
    for (int it = C.bid; it < 4 * 18 * 16; it += C.G) {
        const int l = it / 288, rem = it % 288, nb = rem >> 4, kc = rem & 15;
        __syncthreads();
        for (int e = C.tid; e < 576; e += 512) { const int r = e >> 6, k = e & 63; const float v = r < 8 ? cvec[r * 1024 + kc * 64 + k] : cctx[kc * 64 + k]; cvs[e] = v / (1.f + expf(-v)); }
        __syncthreads();
        const int n = nb * 512 + C.tid;
        float a[9];
#pragma unroll
        for (int r = 0; r < 9; ++r) a[r] = 0.f;
        const float* wp = wmod + ((size_t)l * 1024 + kc * 64) * NMOD + n;
#pragma unroll 8
        for (int k = 0; k < 64; ++k) { const float w = wp[(size_t)k * NMOD];
#pragma unroll
            for (int r = 0; r < 9; ++r) a[r] += cvs[r * 64 + k] * w; }
#pragma unroll
        for (int r = 0; r < 9; ++r) MODP[((size_t)(kc * 4 + l) * 9 + r) * NMOD + n] = a[r];
    }
}
__device__ __forceinline__ void mod_final_phase(const Ctx& C, const float* bmod, const float* normg, const float* MODP, float* MOD, float* GS) {
    for (int e = C.bid * 512 + C.tid; e < 4 * 9 * NMOD; e += C.G * 512) {
        const int l = e / (9 * NMOD), r = (e / NMOD) % 9, n = e % NMOD; float a = bmod[l * NMOD + n];
#pragma unroll
        for (int kc = 0; kc < 16; ++kc) a += MODP[(size_t)kc * (4 * 9 * NMOD) + e];
        MOD[e] = a;
        const int j = n >> 10, c = n & 1023;
        if (j % 3 == 1) { const int k = j / 3; GS[((size_t)(l * 3 + k) * 9 + r) * DM + c] = normg[(l * 3 + k) * DM + c] * (1.f + a); }
    }
}
__device__ __forceinline__ void dft_gen_phase(const Ctx& C, bf16_t* DFT, bf16_t* DFTC) {
    LAS float* tab = (LAS float*)C.lds;
    __syncthreads();
    for (int i = C.tid; i < 4096; i += 512) tab[i] = cosf(6.283185307179586f * (float)i * (1.f / 4096.f));
    __syncthreads();
    const size_t nv = (size_t)4096 * 8192 / 8;
    for (size_t v = (size_t)C.bid * 512 + C.tid; v < nv; v += (size_t)C.G * 512) {
        const int k = (int)(v >> 10), kk0 = (int)(v & 1023) * 8, part = kk0 >> 12, t0 = kk0 & 4095;
        float r[8];
#pragma unroll
        for (int q = 0; q < 8; ++q) { const int idx = (k * (t0 + q)) & 4095; r[q] = (part ? -tab[(idx - 1024) & 4095] : tab[idx]) * (1.f / 64.f); }
        *(u32x4*)(DFT + v * 8) = pack8(r);
    }
    for (int v = C.bid * 512 + C.tid; v < 256 * 512 / 8; v += C.G * 512) {
        const int k = v >> 6, kk0 = (v & 63) * 8, part = kk0 >> 8, t0 = kk0 & 255;
        float r[8];
#pragma unroll
        for (int q = 0; q < 8; ++q) { const int idx = ((k * (t0 + q)) & 255) * 16; r[q] = (part ? -tab[(idx - 1024) & 4095] : tab[idx]) * (1.f / 16.f); }
        *(u32x4*)(DFTC + (size_t)v * 8) = pack8(r);
    }
}
__device__ __forceinline__ void fin_rows_phase(const Ctx& C, float* H, const float* GSk, bf16_t* AN, const float* PART, int nslice, const float* ROWSQ, float* R, bool all_rows) {
    for (int m = (all_rows ? 0 : ML) + C.gw; m < MT; m += C.NGW) {
        const int bi = m < ML ? (m >> 12) : 8;
        f32x4* xr = (f32x4*)(H + (size_t)m * DM) + C.lane;
        f32x4 v[4]; float s = 0.f;
#pragma unroll
        for (int j = 0; j < 4; ++j) v[j] = xr[64 * j];
        if (!all_rows) {
            for (int z = 0; z < nslice; ++z) { const f32x4* pr = (const f32x4*)(PART + ((size_t)z * MC + (m - ML)) * DM) + C.lane;
#pragma unroll
                for (int j = 0; j < 4; ++j) v[j] += pr[64 * j]; }
#pragma unroll
            for (int j = 0; j < 4; ++j) xr[64 * j] = v[j];
        }
#pragma unroll
        for (int j = 0; j < 4; ++j) s += (v[j][0] * v[j][0] + v[j][1] * v[j][1]) + (v[j][2] * v[j][2] + v[j][3] * v[j][3]);
        s = wave_sum(s);
        if (C.lane == 0) R[m] = rsqrtf(s * (1.f / 1024.f) + 1e-6f);
#pragma unroll
        for (int j = 0; j < 4; ++j) { const int c = 4 * (C.lane + 64 * j);
            const f32x4 y = v[j] * *(const f32x4*)(GSk + bi * DM + c);
            u32x2 w; w.x = cvt_pk_bf16(y[0], y[1]); w.y = cvt_pk_bf16(y[2], y[3]);
            *(u32x2*)(AN + (size_t)m * DM + c) = w; }
    }
    if (!all_rows)
        for (int m = C.bid * 512 + C.tid; m < ML; m += C.G * 512) {
            const f32x4* q = (const f32x4*)(ROWSQ + (size_t)m * 16); const f32x4 a = q[0], b = q[1], c = q[2], d = q[3];
            const float s = ((a[0] + a[1]) + (a[2] + a[3])) + ((b[0] + b[1]) + (b[2] + b[3])) + ((c[0] + c[1]) + (c[2] + c[3])) + ((d[0] + d[1]) + (d[2] + d[3]));
            R[m] = rsqrtf(s * (1.f / 1024.f) + 1e-6f);
        }
}
__device__ __forceinline__ void bias_phase(const Ctx& C, const bf16_t* Wt, int nrows, const float* shift  , float* BIAS) {
    for (int n = C.gw; n < nrows; n += C.NGW) {
        const u32x4* wp = (const u32x4*)(Wt + (size_t)n * DM + C.lane * 16);
        float w[16]; { float t0[8], t1[8]; unpack8(wp[0], t0); unpack8(wp[1], t1);
#pragma unroll
            for (int q = 0; q < 8; ++q) { w[q] = t0[q]; w[8 + q] = t1[q]; } }
        for (int bi = 0; bi < 9; ++bi) {
            const f32x4* sp = (const f32x4*)(shift + bi * NMOD + C.lane * 16);
            float a = 0.f;
#pragma unroll
            for (int q = 0; q < 4; ++q) { const f32x4 sv = sp[q]; a += (sv[0] * w[4 * q] + sv[1] * w[4 * q + 1]) + (sv[2] * w[4 * q + 2] + sv[3] * w[4 * q + 3]); }
            a = wave_sum(a);
            if (C.lane == 0) BIAS[bi * nrows + n] = a;
        }
    }
}
__device__ __forceinline__ void final_norm_phase(const Ctx& C, const float* H, const float* gvec, float* out) {
    for (int m = C.gw; m < ML; m += C.NGW) {
        const f32x4* xr = (const f32x4*)(H + (size_t)m * DM) + C.lane;
        f32x4 v[4]; float s = 0.f;
#pragma unroll
        for (int j = 0; j < 4; ++j) { v[j] = xr[64 * j]; s += (v[j][0] * v[j][0] + v[j][1] * v[j][1]) + (v[j][2] * v[j][2] + v[j][3] * v[j][3]); }
        const float r = rsqrtf(wave_sum(s) * (1.f / 1024.f) + 1e-6f);
#pragma unroll
        for (int j = 0; j < 4; ++j) { const int c = 4 * (C.lane + 64 * j); const f32x4 g4 = *(const f32x4*)(gvec + c);
            *(f32x4*)(out + (size_t)m * DM + c) = v[j] * r * g4; }
    }
}

__device__ __forceinline__ void dump_phase(const Ctx& C, const bf16_t* a, const bf16_t* b, float* out) {
    const size_t n = (size_t)ML * 512;
    for (size_t i = (size_t)C.bid * 512 + C.tid; i < n; i += (size_t)C.G * 512) { out[i] = __uint_as_float((unsigned)a[i] << 16); out[n + i] = __uint_as_float((unsigned)b[i] << 16); }
}

#define XB_TMO      128
#define XB_XCNT(j)  (256  + 64 * (j))
#define XB_XSUB(j)  (1280 + 64 * (j))
#define XB_XGEN(j)  (2304 + 64 * (j))
#define XB_TOP      3328
#define XB_TOPGEN   3392
#define XCD_BAR_WORDS 3456
#define XB_SPIN_CAP (1u << 18)
__device__ __forceinline__ unsigned xb_ld(unsigned* p)              { return __hip_atomic_load(p, __ATOMIC_RELAXED, __HIP_MEMORY_SCOPE_AGENT); }
__device__ __forceinline__ unsigned xb_add(unsigned* p, unsigned v) { return __hip_atomic_fetch_add(p, v, __ATOMIC_RELAXED, __HIP_MEMORY_SCOPE_AGENT); }
__device__ __forceinline__ unsigned xb_xcc_id() { return (unsigned)__builtin_amdgcn_s_getreg((3 << 11) | 20) & 0xFu; }
#define XB_SPIN(cond, bar) do { unsigned _sp = 0; while (cond) { __builtin_amdgcn_s_sleep(1); \
    if ((++_sp & 255u) == 0u) { if (xb_ld(&(bar)[XB_TMO])) break; if (_sp > XB_SPIN_CAP) { atomicAdd(&(bar)[XB_TMO], 1u); break; } } } } while (0)
struct XcdBarrier { unsigned* bar; unsigned x; volatile LAS unsigned* st; };
__device__ __forceinline__ void xcd_barrier_complete(unsigned* bar, unsigned x, unsigned& nloc, unsigned& nx) {
    const unsigned G = gridDim.x * gridDim.y * gridDim.z;
    unsigned sum, cnt, mine, sp = 0u;
    for (;;) {
        sum = 0u; cnt = 0u; mine = 0u;
#pragma unroll
        for (unsigned j = 0; j < 16; ++j) { const unsigned c = xb_ld(&bar[XB_XCNT(j)]); sum += c; cnt += (c > 0u) ? 1u : 0u; mine = (j == x) ? c : mine; }
        if (sum == G) break;
        __builtin_amdgcn_s_sleep(1);
        if ((++sp & 255u) == 0u) { if (xb_ld(&bar[XB_TMO])) break; if (sp > XB_SPIN_CAP) { atomicAdd(&bar[XB_TMO], 1u); break; } }
    }
    nloc = mine > 0u ? mine : 1u; nx = cnt > 0u ? cnt : 1u;
}
__device__ __forceinline__ void xcd_barrier(const XcdBarrier& b) {
    asm volatile("s_waitcnt vmcnt(0)" ::: "memory");
    __syncthreads();
    if (threadIdx.x == 0) {
        unsigned* bar = b.bar;
        __builtin_amdgcn_s_waitcnt(0);
        unsigned nloc = b.st[0], nx = b.st[1];
        if (nloc == 0u) { xcd_barrier_complete(bar, b.x, nloc, nx); b.st[0] = nloc; b.st[1] = nx; }
        const unsigned old = xb_add(&bar[XB_XSUB(b.x)], 1u);
        const unsigned gen = old / nloc;
        if (old + 1u == (gen + 1u) * nloc) {
            __builtin_amdgcn_fence(__ATOMIC_RELEASE, "agent");
            asm volatile("s_waitcnt vmcnt(0)" ::: "memory");
            const unsigned og = xb_add(&bar[XB_TOP], 1u);
            const unsigned tg = og / nx;
            if (og + 1u == (tg + 1u) * nx) xb_add(&bar[XB_TOPGEN], 1u);
            else XB_SPIN(xb_ld(&bar[XB_TOPGEN]) == tg, bar);
            __builtin_amdgcn_fence(__ATOMIC_ACQUIRE, "agent");
            xb_add(&bar[XB_XGEN(b.x)], 1u);
            asm volatile("s_waitcnt vmcnt(0)" ::: "memory");
        } else {
            XB_SPIN(xb_ld(&bar[XB_XGEN(b.x)]) == gen, bar);
            __builtin_amdgcn_fence(__ATOMIC_ACQUIRE, "agent");
            asm volatile("s_waitcnt vmcnt(0)" ::: "memory");
        }
    }
    __syncthreads();
}
#define GRID_SYNC_CG() do { asm volatile("s_waitcnt vmcnt(0) lgkmcnt(0)" ::: "memory"); grid.sync(); __builtin_amdgcn_fence(__ATOMIC_ACQUIRE, "agent"); asm volatile("s_waitcnt vmcnt(0)" ::: "memory"); } while (0)
#define GRID_SYNC() do { XcdBarrier _xb; _xb.bar = (unsigned*)(WSBASE() + WS_CTL); _xb.x = xb_xcc_id(); _xb.st = (volatile LAS unsigned*)(C.lds + 131072 + 512); xcd_barrier(_xb); } while (0)
struct Args { const float* in[25]; float* out; unsigned char* ws; };

__device__ __forceinline__ void* ldptr(LAS unsigned long long* PT, int i) {
    unsigned off = 8u * (unsigned)i; asm volatile("" : "+s"(off));
    const unsigned long long v = *(LAS unsigned long long*)((LAS unsigned char*)PT + off);
    unsigned lo = __builtin_amdgcn_readfirstlane((unsigned)v), hi = __builtin_amdgcn_readfirstlane((unsigned)(v >> 32));
    asm volatile("" : "+s"(lo), "+s"(hi));
    return (void*)(((unsigned long long)hi << 32) | lo);
}
#define INP(i) ((const float*)ldptr(PT, i))
#define WSBASE() ((unsigned char*)ldptr(PT, 26))
#define OUTP ((float*)ldptr(PT, 25))
#define XIN INP(0)
#define cvec INP(1)
#define ctxin INP(2)
#define cctx INP(3)
#define wmod INP(4)
#define bmod INP(5)
#define normg INP(6)
#define f1w13 INP(7)
#define f1w2 INP(8)
#define win INP(9)
#define wfo INP(10)
#define LRE INP(11)
#define LIM INP(12)
#define LST INP(13)
#define BRE INP(14)
#define BIM INP(15)
#define CRE INP(16)
#define CIM INP(17)
#define SDD INP(18)
#define wglu INP(19)
#define wsso INP(20)
#define wout INP(21)
#define f2w13 INP(22)
#define f2w2 INP(23)
#define fing INP(24)
#define H ((float*)(WSBASE() + WS_H))
#define MOD ((float*)(WSBASE() + WS_MOD))
#define MODP ((float*)(WSBASE() + X_MODP))
#define HID ((bf16_t*)(WSBASE() + X_HID))
#define AN_FFN ((bf16_t*)(WSBASE() + X_AN_FFN))
#define AN_MIX ((bf16_t*)(WSBASE() + X_AN_MIX))
#define VT2 ((bf16_t*)(WSBASE() + X_VT2))
#define VT2C ((bf16_t*)(WSBASE() + X_VT2C))
#define SGF ((bf16_t*)(WSBASE() + X_SGF))
#define SGS ((bf16_t*)(WSBASE() + X_SGS))
#define UG ((bf16_t*)(WSBASE() + X_UG))
#define HIN ((bf16_t*)(WSBASE() + X_UG))
#define SB ((float*)(WSBASE() + X_S))
#define YS ((bf16_t*)(WSBASE() + X_YS))
#define ZG ((bf16_t*)(WSBASE() + X_ZG))
#define YF ((bf16_t*)(WSBASE() + X_YF))
#define YI ((bf16_t*)(WSBASE() + X_YI))
#define DFT ((bf16_t*)(WSBASE() + WS_DFT))
#define DFTC ((bf16_t*)(WSBASE() + WS_DFTC))
#define W13 ((bf16_t*)(WSBASE() + W_13))
#define W2 ((bf16_t*)(WSBASE() + W_2))
#define WIN ((bf16_t*)(WSBASE() + W_IN))
#define WFO ((bf16_t*)(WSBASE() + W_FO))
#define WGLU ((bf16_t*)(WSBASE() + W_GLU))
#define WSSO ((bf16_t*)(WSBASE() + W_SSO))
#define WOUT ((bf16_t*)(WSBASE() + W_OUT))
#define WSA ((bf16_t*)(WSBASE() + W_SA))
#define WSB ((bf16_t*)(WSBASE() + W_SB))
#define PART ((float*)(WSBASE() + WS_PART))
#define GSK(l_, k_) ((float*)(WSBASE() + WS_GS) + (size_t)((l_) * 3 + (k_)) * 9 * DM)
#define RVEC ((float*)(WSBASE() + WS_R))
#define ROWSQ ((float*)(WSBASE() + WS_ROWSQ))
#define BIASF ((float*)(WSBASE() + WS_BIASF))
#define BIASM ((float*)(WSBASE() + WS_BIASM))
__global__ void __launch_bounds__(512, 2) fwd_mega(Args args) {
    extern __shared__ __attribute__((aligned(16))) unsigned char lds_raw[];
    cg::grid_group grid = cg::this_grid();
    Ctx C; C.lds = (LAS unsigned char*)lds_raw; C.tid = threadIdx.x; C.lane = C.tid & 63; C.wave = __builtin_amdgcn_readfirstlane(C.tid >> 6);
    C.G = gridDim.x; C.bid = blockIdx.x; C.gw = C.bid * 8 + C.wave; C.NGW = C.G * 8;
    LAS unsigned long long* PT = (LAS unsigned long long*)(C.lds + 131072);
    if (threadIdx.x == 0) {
        PT[0] = (unsigned long long)args.in[0]; PT[1] = (unsigned long long)args.in[1]; PT[2] = (unsigned long long)args.in[2]; PT[3] = (unsigned long long)args.in[3]; PT[4] = (unsigned long long)args.in[4];
        PT[5] = (unsigned long long)args.in[5]; PT[6] = (unsigned long long)args.in[6]; PT[7] = (unsigned long long)args.in[7]; PT[8] = (unsigned long long)args.in[8]; PT[9] = (unsigned long long)args.in[9];
        PT[10] = (unsigned long long)args.in[10]; PT[11] = (unsigned long long)args.in[11]; PT[12] = (unsigned long long)args.in[12]; PT[13] = (unsigned long long)args.in[13]; PT[14] = (unsigned long long)args.in[14];
        PT[15] = (unsigned long long)args.in[15]; PT[16] = (unsigned long long)args.in[16]; PT[17] = (unsigned long long)args.in[17]; PT[18] = (unsigned long long)args.in[18]; PT[19] = (unsigned long long)args.in[19];
        PT[20] = (unsigned long long)args.in[20]; PT[21] = (unsigned long long)args.in[21]; PT[22] = (unsigned long long)args.in[22]; PT[23] = (unsigned long long)args.in[23]; PT[24] = (unsigned long long)args.in[24];
        PT[25] = (unsigned long long)args.out; PT[26] = (unsigned long long)args.ws;
        volatile LAS unsigned* st = (volatile LAS unsigned*)(C.lds + 131072 + 512); st[0] = 0u; st[1] = 0u;
        (void)xb_add((unsigned*)(args.ws + WS_CTL) + XB_XCNT(xb_xcc_id()), 1u);
    }
    __syncthreads();
    const int G = C.G, bid = C.bid;

    {
        const size_t nl = (size_t)ML * DM / 4, nc = (size_t)MC * DM / 4;
        for (size_t i = (size_t)bid * 512 + C.tid; i < nl + nc; i += (size_t)G * 512) ((f32x4*)H)[i] = i < nl ? ((const f32x4*)XIN)[i] : ((const f32x4*)ctxin)[i - nl];
        mod_partial_phase(C, cvec, cctx, wmod, MODP);
        dft_gen_phase(C, DFT, DFTC);
    }
    GRID_SYNC_CG();
    mod_final_phase(C, bmod, normg, MODP, MOD, GSK(0, 0));

    for (int l = 0; l < DEPTH; ++l) {
#define MODl (MOD + (size_t)l * 9 * NMOD)
#define MKP(P) SsmP P; P.lre = LRE + l * 4096; P.lim = LIM + l * 4096; P.lst = LST + l * 64; P.bre = BRE + (size_t)l * 65536; P.bim = BIM + (size_t)l * 65536; \
        P.cre = CRE + (size_t)l * 65536; P.cim = CIM + (size_t)l * 65536; P.dd = SDD + l * 512;
#ifndef NO_PREP
        CTX_REFRESH(C);
        __syncthreads();
        transpose_mat(C, f1w13 + (size_t)l * 1024 * 5632, 1024, 5632, 0, 5632, W13, 1, 2816, 0);
        transpose_mat(C, f1w2 + (size_t)l * 2816 * 1024, 2816, 1024, 0, 1024, W2, 0, 0, 0);
        transpose_mat(C, win + (size_t)l * 1024 * 3072, 1024, 3072, 512, 2560, WIN, 0, 0, 1024);
        transpose_mat(C, wfo + (size_t)l * 512 * 1024, 512, 1024, 0, 1024, WFO, 0, 0, 0);
        transpose_mat(C, wglu + (size_t)l * 512 * 1024, 512, 1024, 0, 1024, WGLU, 1, 512, 0);
        transpose_mat(C, wsso + (size_t)l * 512 * 1024, 512, 1024, 0, 1024, WSSO, 0, 0, 0);
        transpose_mat(C, wout + (size_t)l * 1024 * 1024, 1024, 1024, 0, 1024, WOUT, 0, 0, 0);
        __syncthreads();
        CTX_REFRESH(C);
        fourier_weight_phase(C, win + (size_t)l * 1024 * 3072, WIN);
        CTX_REFRESH(C);
        { MKP(P) ssm_mats_phase(C, P, WSA, WSB); }
#endif
        GRID_SYNC(); CTX_REFRESH(C);

        for (int f = 0; f < 2; ++f) {
#ifndef NO_MIX
            if (f == 1) {
                fin_rows_phase(C, H, GSK(l, 1), AN_MIX, PART, 2, ROWSQ, RVEC, false);
                CTX_REFRESH(C);
                __syncthreads();
                transpose_mat(C, f2w13 + (size_t)l * 1024 * 5632, 1024, 5632, 0, 5632, W13, 1, 2816, 0);
                transpose_mat(C, f2w2 + (size_t)l * 2816 * 1024, 2816, 1024, 0, 1024, W2, 0, 0, 0);
                __syncthreads();
                GRID_SYNC(); CTX_REFRESH(C);
#if defined(DUMP) && DUMP == 8
                {
                    pg8::Sched S; S.init(AN_MIX, W13, MT / 256, 22, 1, 1024, 1024, 0, 0, G, bid);
                    EpiPair<0> E{HID, DFF, RVEC, BIASF}; pg8::gemm_phase(C.lds, C.wave, 1024, 1024, 1024, S, E);
                }
                GRID_SYNC(); CTX_REFRESH(C);
                dump_phase(C, HID, HID + (size_t)ML * 512, OUTP); return;
#endif
#if defined(DUMP) && DUMP == 5
                dump_phase(C, AN_MIX, AN_MIX + (size_t)ML * 512, OUTP); return;
#endif
#if defined(DUMP) && DUMP == 6
                { const size_t nw = (size_t)24 * MiB / 2, nall = (size_t)ML * DM;
                  for (size_t i = (size_t)C.bid * 512 + C.tid; i < nall; i += (size_t)C.G * 512) OUTP[i] = i < nw ? __uint_as_float((unsigned)WIN[i] << 16) : 0.f; }
                return;
#endif
#if (MIXSEL >> 0) & 1
                {
                    pg8::Sched S; S.init(WIN, AN_MIX, 4, MT / 256, 1, 1024, 1024, 0, 0, G, bid);
                    EpiInT E{VT2, VT2C, RVEC, BIASM}; pg8::gemm_phase(C.lds, C.wave, 1024, 1024, 1024, S, E);
                }
#endif
#if (MIXSEL >> 1) & 1
                {
                    pg8::Sched S; S.init(AN_MIX, WIN + (size_t)1024 * 1024, MT / 256, 2, 1, 1024, 1024, 0, 0, G, (bid + 32) % G);
                    EpiInU E{UG, RVEC, BIASM}; pg8::gemm_phase(C.lds, C.wave, 1024, 1024, 1024, S, E);
                }
                {
                    pg8::Sched S; S.init(AN_MIX, WIN + (size_t)1536 * 1024, MT / 256, 8, 1, 1024, 1024, 0, 0, G, (bid + 192) % G);
                    EpiInG E{SGF, SGS, RVEC, BIASM}; pg8::gemm_phase(C.lds, C.wave, 1024, 1024, 1024, S, E);
                }
#endif
                GRID_SYNC(); CTX_REFRESH(C);
#if defined(DUMP) && DUMP == 3
                dump_phase(C, SGF, SGS, OUTP); return;
#endif
#if defined(DUMP) && DUMP == 4
                dump_phase(C, VT2, VT2 + (size_t)ML * 512, OUTP); return;
#endif
#if (MIXSEL >> 2) & 1
                {
                    pg8::Sched S; S.init(DFT, VT2, 16, 2, 8, 8192, 8192, 0, (size_t)512 * 8192, G, bid);
                    EpiF2 E{YF, 0, 4096, 512}; pg8::gemm_phase(C.lds, C.wave, 8192, 8192, 8192, S, E);
                }
#endif
#if (MIXSEL >> 3) & 1
                {
                    pg8::Sched S; S.init(DFTC, VT2C, 1, 2, 8, 512, 512, 0, (size_t)512 * 512, G, bid);
                    EpiF2 E{YF, ML, 256, 512}; pg8::gemm_phase(C.lds, C.wave, 512, 512, 512, S, E);
                }
#endif
                GRID_SYNC(); CTX_REFRESH(C);
#if defined(DUMP) && DUMP == 1
                dump_phase(C, YF, SGS, OUTP); return;
#endif
#if (MIXSEL >> 4) & 1
                {
                    pg8::Sched S; S.init(UG, WSA, 9, 2, 32, 256, 256, (size_t)UROWS * 256, (size_t)512 * 256, G, bid);
                    EpiSsmA E{YI, SB}; pg8::gemm_phase(C.lds, C.wave, 256, 256, 256, S, E);
                }
#endif
#if (MIXSEL >> 5) & 1
                {
                    pg8::Sched S; S.init(YF, WFO, MT / 256, 4, 1, 512, 512, 0, 0, G, (bid + 64) % G);
                    EpiFo E{SGF}; pg8::gemm_phase(C.lds, C.wave, 512, 512, 512, S, E);
                }
#endif
                GRID_SYNC(); CTX_REFRESH(C);
                { MKP(P) ssm_scan_phase(C, P, SB, HIN); }
                GRID_SYNC(); CTX_REFRESH(C);
#if (MIXSEL >> 6) & 1
                {
                    pg8::Sched S; S.init(HIN, WSB, 9, 1, 32, 256, 256, (size_t)UROWS * 256, (size_t)256 * 256, G, bid);
                    EpiSsmB E{YI, YS}; pg8::gemm_phase(C.lds, C.wave, 256, 256, 256, S, E);
                }
#endif
                GRID_SYNC(); CTX_REFRESH(C);
#if defined(DUMP) && DUMP == 2
                dump_phase(C, YS, SGF, OUTP); return;
#endif
#if (MIXSEL >> 7) & 1
                {
                    pg8::Sched S; S.init(YS, WGLU, MT / 256, 4, 1, 512, 512, 0, 0, G, bid);
                    EpiPair<1> E{ZG, 512, nullptr, nullptr}; pg8::gemm_phase(C.lds, C.wave, 512, 512, 512, S, E);
                }
#endif
                GRID_SYNC(); CTX_REFRESH(C);
#if (MIXSEL >> 8) & 1
                {
                    pg8::Sched S; S.init(ZG, WSSO, MT / 256, 4, 1, 512, 512, 0, 0, G, bid);
                    EpiSso E{SGS, SGF}; pg8::gemm_phase(C.lds, C.wave, 512, 512, 512, S, E);
                }
#endif
                GRID_SYNC(); CTX_REFRESH(C);
#if (MIXSEL >> 9) & 1
                {
                    pg8::Sched S; S.init(SGS, WOUT, ML / 256, 4, 1, 1024, 1024, 0, 0, G, bid);
                    EpiRes<false, false> E{H, MODl + 5 * 1024, PART, GSK(l, 2), AN_FFN, ROWSQ}; pg8::gemm_phase(C.lds, C.wave, 1024, 1024, 1024, S, E);
                }
                {
                    pg8::Sched S; S.init(SGS + (size_t)ML * 1024, WOUT, MC / 256, 4, 4, 1024, 1024, 256, 256, G, (bid + G / 2) % G);
                    EpiRes<true, false> E{H, MODl + 5 * 1024, PART, nullptr, nullptr, nullptr}; pg8::gemm_phase(C.lds, C.wave, 256, 1024, 1024, S, E);
                }
#endif
                GRID_SYNC(); CTX_REFRESH(C);
            }
#endif
#ifndef NO_FFN
            const int kb = f == 0 ? 0 : 6;
            if (f == 0) { fin_rows_phase(C, H, GSK(l, 0), AN_FFN, PART, 2, ROWSQ, RVEC, l == 0);
                          bias_phase(C, W13, 5632, MODl, BIASF); bias_phase(C, WIN, 3584, MODl + 3 * 1024, BIASM); }
            else        { fin_rows_phase(C, H, GSK(l, 2), AN_FFN, PART, 4, ROWSQ, RVEC, false);
                          bias_phase(C, W13, 5632, MODl + 6 * 1024, BIASF); }
            GRID_SYNC(); CTX_REFRESH(C);
            {
                pg8::Sched S; S.init(AN_FFN, W13, MT / 256, 22, 1, 1024, 1024, 0, 0, G, bid);
                EpiPair<0> E{HID, DFF, RVEC, BIASF}; pg8::gemm_phase(C.lds, C.wave, 1024, 1024, 1024, S, E);
            }
            GRID_SYNC(); CTX_REFRESH(C);
            {
                pg8::Sched S; S.init(HID, W2, ML / 256, 4, 1, DFF, DFF, 0, 0, G, bid);
                EpiRes<false, true> E{H, MODl + (kb + 2) * 1024, PART, f == 0 ? GSK(l, 1) : GSK(l < 3 ? l + 1 : 3, 0), f == 0 ? AN_MIX : AN_FFN, ROWSQ}; pg8::gemm_phase(C.lds, C.wave, DFF, DFF, DFF, S, E);
            }
            {
                pg8::Sched S; S.init(HID + (size_t)ML * DFF, W2, MC / 256, 4, 2, DFF, DFF, 1408, 1408, G, (bid + G / 2) % G);
                EpiRes<true, true> E{H, MODl + (kb + 2) * 1024, PART, nullptr, nullptr, nullptr}; pg8::gemm_phase(C.lds, C.wave, 1408, DFF, DFF, S, E);
            }
            GRID_SYNC(); CTX_REFRESH(C);
#endif
        }
    }
    CTX_REFRESH(C);
    final_norm_phase(C, H, fing, OUTP);
}

extern "C" void kernel_launch(void* const* d_in, const int* in_sizes, int n_in, void* d_out, int out_size, void* d_ws, size_t ws_size, hipStream_t stream) {
    static int grid = 0;
    if (grid == 0) {
        if (n_in != 25 || ws_size < WS_END) { fprintf(stderr, "kernel_launch: bad n_in %d or ws_size %zu < %zu\n", n_in, ws_size, (size_t)WS_END); grid = -1; return; }
        int dev = 0, cus = 0, per_cu = 0;
        (void)hipGetDevice(&dev);
        (void)hipDeviceGetAttribute(&cus, hipDeviceAttributeMultiprocessorCount, dev);
        (void)hipFuncSetAttribute((const void*)fwd_mega, hipFuncAttributeMaxDynamicSharedMemorySize, LDS_BYTES);
        (void)hipOccupancyMaxActiveBlocksPerMultiprocessor(&per_cu, (const void*)fwd_mega, 512, LDS_BYTES);
        if (per_cu < 1) per_cu = 1;
        grid = cus * 1;
        if (grid < 160) { fprintf(stderr, "kernel_launch: needs >= 160 CUs (got %d)\n", grid); grid = -1; return; }
        fprintf(stderr, "kernel_launch: grid %d (cus %d, per_cu %d), ws %zu\n", grid, cus, per_cu, ws_size);
    }
    if (grid < 0) return;
    if (hipMemsetAsync((char*)d_ws + WS_CTL, 0, CTL_BYTES, stream) != hipSuccess) { fprintf(stderr, "kernel_launch: memset of the barrier words failed\n"); return; }
    Args a{};
    for (int i = 0; i < 25; ++i) a.in[i] = (const float*)d_in[i];
    a.out = (float*)d_out; a.ws = (unsigned char*)d_ws;
    void* kargs[] = {&a};
    hipError_t e = hipLaunchCooperativeKernel((const void*)fwd_mega, dim3(grid), dim3(512), kargs, LDS_BYTES, stream);
    if (e != hipSuccess) fprintf(stderr, "kernel_launch: cooperative launch failed: %s\n", hipGetErrorString(e));
}
```

```cpp
#include <hip/hip_runtime.h>
#include <hip/hip_cooperative_groups.h>
#include <cstdio>
#include <cstdint>
namespace cg = cooperative_groups;
#ifndef MIXSEL
#define MIXSEL 0xffff
#endif

#define LAS __attribute__((address_space(3)))
typedef unsigned short bf16_t;
typedef short bf16x8 __attribute__((ext_vector_type(8)));
typedef float f32x4 __attribute__((ext_vector_type(4)));
typedef float f32x2 __attribute__((ext_vector_type(2)));
typedef unsigned u32x4 __attribute__((ext_vector_type(4)));
typedef unsigned u32x2 __attribute__((ext_vector_type(2)));

constexpr int DM = 1024, NB = 8, SEQ = 4096, CTX = 256, DEPTH = 4, DFF = 2816;
constexpr int ML = NB * SEQ, MC = NB * CTX, MT = ML + MC;
constexpr int NMOD = 9 * DM;
constexpr int UROWS = 2304;

constexpr size_t MiB = 1u << 20;
constexpr size_t WS_H = 0;
constexpr size_t WS_X = 136 * MiB;
constexpr size_t X_HID = WS_X;
constexpr size_t X_AN_FFN = WS_X + 276 * MiB;
constexpr size_t X_VT2 = WS_X;
constexpr size_t X_VT2C = WS_X + 64 * MiB;
constexpr size_t X_SGF = WS_X + 68 * MiB;
constexpr size_t X_SGS = WS_X + 136 * MiB;
constexpr size_t X_UG = WS_X + 204 * MiB;
constexpr size_t X_S = WS_X + 240 * MiB;
constexpr size_t X_AN_MIX = X_S;
constexpr size_t X_YS = X_S;
constexpr size_t X_ZG = X_S + 34 * MiB;
constexpr size_t X_YF = WS_X + 312 * MiB;
constexpr size_t X_YI = WS_X;
constexpr size_t X_MODP = WS_X;
constexpr size_t WS_DFT = 482 * MiB;
constexpr size_t WS_DFTC = 546 * MiB;
constexpr size_t WS_W = 547 * MiB;
constexpr size_t W_13 = WS_W;
constexpr size_t W_2 = WS_W + 11 * MiB;
constexpr size_t W_IN = WS_W + 17 * MiB;
constexpr size_t W_FO = WS_W + 24 * MiB;
constexpr size_t W_GLU = WS_W + 25 * MiB;
constexpr size_t W_SSO = WS_W + 26 * MiB;
constexpr size_t W_OUT = WS_W + 27 * MiB;
constexpr size_t W_SA = WS_W + 29 * MiB;
constexpr size_t W_SB = WS_W + 37 * MiB;
constexpr size_t WS_MOD = 588 * MiB;
constexpr size_t WS_PART = WS_X + 204 * MiB;
constexpr size_t WS_GS = WS_MOD + 1408 * 1024;
constexpr size_t WS_R = WS_MOD + 1856 * 1024;
constexpr size_t WS_ROWSQ = 590 * MiB;
constexpr size_t WS_BIASF = 592 * MiB + 256 * 1024;
constexpr size_t WS_BIASM = 592 * MiB + 512 * 1024;
constexpr size_t WS_CTL = 594 * MiB;
constexpr size_t CTL_BYTES = 16384;
constexpr size_t W_13B = 595 * MiB;
constexpr size_t W_2B = 606 * MiB;
constexpr size_t WS_END = 612 * MiB;

constexpr int LDS_BYTES = 139264;

__device__ __forceinline__ unsigned cvt_pk_bf16(float lo, float hi) { unsigned r; asm volatile("s_nop 1\n\tv_cvt_pk_bf16_f32 %0, %1, %2" : "=v"(r) : "v"(lo), "v"(hi)); return r; }
__device__ __forceinline__ float bf_lo(unsigned w) { return __uint_as_float(w << 16); }
__device__ __forceinline__ float bf_hi(unsigned w) { return __uint_as_float(w & 0xffff0000u); }
__device__ __forceinline__ float sigmoidf_(float x) { return __builtin_amdgcn_rcpf(1.f + __expf(-x)); }
__device__ __forceinline__ float siluf_(float x) { return x * sigmoidf_(x); }
__device__ __forceinline__ float gelu_tanh(float y) { const float u = 0.7978845608028654f * (y + 0.044715f * y * y * y); return y * sigmoidf_(2.f * u); }
__device__ __forceinline__ float wave_sum(float v) {
#pragma unroll
    for (int o = 1; o < 64; o <<= 1) v += __shfl_xor(v, o);
    return v;
}
__device__ __forceinline__ u32x4 pack8(const float (&r)[8]) { u32x4 w; w.x = cvt_pk_bf16(r[0], r[1]); w.y = cvt_pk_bf16(r[2], r[3]); w.z = cvt_pk_bf16(r[4], r[5]); w.w = cvt_pk_bf16(r[6], r[7]); return w; }
__device__ __forceinline__ void unpack8(const u32x4 w, float (&r)[8]) { r[0] = bf_lo(w.x); r[1] = bf_hi(w.x); r[2] = bf_lo(w.y); r[3] = bf_hi(w.y); r[4] = bf_lo(w.z); r[5] = bf_hi(w.z); r[6] = bf_lo(w.w); r[7] = bf_hi(w.w); }

namespace pg8 {
constexpr int BM = 256, BK = 64, HALF = 128, HTB = HALF * BK * 2, STAGE_BYTES = 8 * HTB, NXCD = 8, WGM = 8;
__host__ __device__ __forceinline__ int lds_byte(int r, int c) { const int st = (r >> 4) * 2 + (c >> 5), rr = r & 15, cc = c & 31, ob = rr * 64 + cc * 2; return st * 1024 + (ob ^ (((ob >> 9) & 1) << 5)); }
__host__ __device__ __forceinline__ void stage_rc(int b, int& R, int& C) { const int st = b / 1024, sb = b % 1024, swz = sb ^ (((sb >> 9) & 1) << 5); R = (st >> 1) * 16 + swz / 64; C = (st & 1) * 32 + (swz % 64) / 2; }
__host__ __device__ __forceinline__ int perm32(int rho) { const int n = rho >> 4, i = rho & 15; return 8 * (i >> 2) + 4 * n + (i & 3); }

struct Unit { int pm, pn, z; const char* a; const char* b; };

struct Sched {
    int nM, nN, nwg, G, c, per_z; const char* A; const char* B; size_t tA, tB, zA, zB; int bsplit; size_t boff;
    __device__ __forceinline__ void init(const void* A_, const void* B_, int nM_, int nN_, int nZ, size_t lda, size_t ldb, size_t zA_el, size_t zB_el, int G_, int c_) {
        A = (const char*)A_; B = (const char*)B_; nM = nM_; nN = nN_; per_z = nM_ * nN_; nwg = per_z * nZ; G = G_; c = c_;
        tA = (size_t)BM * lda * 2; tB = (size_t)BM * ldb * 2; zA = zA_el * 2; zB = zB_el * 2; bsplit = 1 << 30; boff = 0;
    }
    __device__ __forceinline__ bool next(int i, Unit& u) const {
        const long L = (long)i * G + c; if (L >= nwg) return false;
        int wgid = (int)L; { const int q = nwg / NXCD, r = nwg % NXCD, xcd = wgid % NXCD, off = wgid / NXCD; wgid = (xcd < r ? xcd * (q + 1) : r * (q + 1) + (xcd - r) * q) + off; }
        const int z = wgid / per_z, w = wgid % per_z;
        const int nig = WGM * nN, gid = w / nig, fm = gid * WGM, gsz = (nM - fm) < WGM ? (nM - fm) : WGM;
        u.pm = fm + ((w % nig) % gsz); u.pn = (w % nig) / gsz; u.z = z;
        u.a = A + (size_t)z * zA + (size_t)u.pm * tA; u.b = B + (size_t)z * zB + (size_t)u.pn * tB + (u.pm >= bsplit ? boff : 0); return true;
    }
};

template <class Epi>
__device__ __forceinline__ void gemm_phase(LAS unsigned char* lds, const int wave_id, const int K_, const int lda_, const int ldb_, const Sched& S, const Epi& E) {
    int K = K_, lda = lda_, ldb = ldb_; asm volatile("" : "+s"(K), "+s"(lda), "+s"(ldb));
    const int lane = (int)__builtin_amdgcn_mbcnt_hi(~0u, __builtin_amdgcn_mbcnt_lo(~0u, 0u));
    int tid = (wave_id << 6) | lane; asm volatile("" : "+v"(tid));
    const int wid = wave_id, wr = wid >> 2, wc = wid & 3, fr = lane & 15, fq = lane >> 4;
    const int nt = K / BK;
    unsigned voffA[2], voffB[2];
#pragma unroll
    for (int i = 0; i < 2; ++i) { int R, C; stage_rc(tid * 16 + i * 8192, R, C); const int Rb = (R & ~31) + perm32(R & 31);
        voffA[i] = (unsigned)(R * lda + C) * 2u; voffB[i] = (unsigned)(Rb * ldb + C) * 2u; }
    const size_t kstep = (size_t)(BK * 2);
    const size_t hstepA = (size_t)HALF * lda * 2, hstepB = (size_t)HALF * ldb * 2;
    const unsigned ldsw = (unsigned)wid * 1024u;
    const int aoff = lds_byte(wr * 64 + fr, fq * 8), boff = lds_byte(wc * 32 + fr, fq * 8);
#define PG8_SA(b, h) (((b) * 2 + (h)) * HTB)
#define PG8_SB(b, h) ((4 + (b) * 2 + (h)) * HTB)
#define PG8_STAGE(bufoff, gbase, voff) do { const char* _g = (const char*)(gbase); asm volatile("" : "+s"(_g)); _Pragma("unroll") for (int _i = 0; _i < 2; ++_i) \
        __builtin_amdgcn_global_load_lds((const unsigned*)(_g + (voff)[_i]), (LAS unsigned*)(lds + (bufoff) + ldsw + _i * 8192), 16, 0, 0); } while (0)
#define PG8_LDA(dst, b, h) do { _Pragma("unroll") for (int m = 0; m < 4; ++m) _Pragma("unroll") for (int k = 0; k < 2; ++k) dst[m][k] = *(const LAS bf16x8*)(lds + PG8_SA(b, h) + aoff + m * 2048 + k * 1024); } while (0)
#define PG8_LDB(dst, b, h) do { _Pragma("unroll") for (int n = 0; n < 2; ++n) _Pragma("unroll") for (int k = 0; k < 2; ++k) dst[n][k] = *(const LAS bf16x8*)(lds + PG8_SB(b, h) + boff + n * 2048 + k * 1024); } while (0)
#define PG8_MMA(ai, bj, At, Bt) do { __builtin_amdgcn_s_setprio(1); _Pragma("unroll") for (int m = 0; m < 4; ++m) _Pragma("unroll") for (int n = 0; n < 2; ++n) _Pragma("unroll") for (int k = 0; k < 2; ++k) \
        acc[ai][bj][m][n] = __builtin_amdgcn_mfma_f32_16x16x32_bf16(Bt[n][k], At[m][k], acc[ai][bj][m][n], 0, 0, 0); __builtin_amdgcn_s_setprio(0); } while (0)
#define PG8_WAIT_V(n) asm volatile("s_waitcnt vmcnt(" #n ")" ::: "memory")
#define PG8_WAIT_L(n) asm volatile("s_waitcnt lgkmcnt(" #n ")" ::: "memory")
#define PG8_BAR __builtin_amdgcn_s_barrier()
#define PG8_SCHED __builtin_amdgcn_sched_barrier(0)
    Unit cur, nxt; int ui = 0;
    if (!S.next(0, cur)) return;
    f32x4 acc[2][2][4][2];
#pragma unroll
    for (int a = 0; a < 2; ++a)
#pragma unroll
        for (int b = 0; b < 2; ++b)
#pragma unroll
            for (int m = 0; m < 4; ++m)
#pragma unroll
                for (int n = 0; n < 2; ++n) acc[a][b][m][n] = (f32x4){0.f, 0.f, 0.f, 0.f};
    bf16x8 At[4][2], B0[2][2], B1[2][2];
    const char* cA = cur.a; const char* cB = cur.b;
    PG8_STAGE(PG8_SB(0, 0), cB, voffB); PG8_STAGE(PG8_SB(0, 1), cB + hstepB, voffB); PG8_STAGE(PG8_SA(0, 0), cA, voffA); PG8_STAGE(PG8_SA(0, 1), cA + hstepA, voffA);
    if (wr == 1) PG8_BAR;
    PG8_WAIT_V(2); PG8_BAR;
    PG8_STAGE(PG8_SB(1, 0), cB + kstep, voffB); PG8_STAGE(PG8_SA(1, 0), cA + kstep, voffA); PG8_STAGE(PG8_SB(1, 1), cB + hstepB + kstep, voffB);
    PG8_WAIT_V(6); PG8_BAR;
    for (;;) {
        const bool has_next = S.next(ui + 1, nxt);
        const char* nA = has_next ? nxt.a : cA; const char* nB = has_next ? nxt.b : cB;
        for (int t = 0; t < nt; t += 2) {
            const bool last = (t == nt - 2);
            const char* a1 = cA + (size_t)(t + 1) * kstep;
            const char* a2 = last ? nA : cA + (size_t)(t + 2) * kstep; const char* b2 = last ? nB : cB + (size_t)(t + 2) * kstep;
            const char* a3 = a2 + kstep; const char* b3 = b2 + kstep;
            PG8_LDB(B0, 0, 0); PG8_LDB(B1, 0, 1); PG8_SCHED; PG8_LDA(At, 0, 0); PG8_STAGE(PG8_SA(1, 1), a1 + hstepA, voffA);
            PG8_WAIT_V(8); PG8_WAIT_L(0); PG8_BAR; PG8_MMA(0, 0, At, B0); PG8_MMA(0, 1, At, B1); PG8_BAR; PG8_SCHED;
            PG8_LDA(At, 0, 1); PG8_STAGE(PG8_SB(0, 0), b2, voffB); PG8_STAGE(PG8_SB(0, 1), b2 + hstepB, voffB); PG8_STAGE(PG8_SA(0, 0), a2, voffA);
            PG8_WAIT_V(8); PG8_WAIT_L(0); PG8_BAR; PG8_MMA(1, 0, At, B0); PG8_MMA(1, 1, At, B1); PG8_BAR; PG8_SCHED;
            PG8_LDB(B0, 1, 0); PG8_LDB(B1, 1, 1); PG8_SCHED; PG8_LDA(At, 1, 0); PG8_STAGE(PG8_SA(0, 1), a2 + hstepA, voffA);
            PG8_WAIT_V(8); PG8_WAIT_L(0); PG8_BAR; PG8_MMA(0, 0, At, B0); PG8_MMA(0, 1, At, B1); PG8_BAR; PG8_SCHED;
            PG8_LDA(At, 1, 1); PG8_STAGE(PG8_SB(1, 0), b3, voffB); PG8_STAGE(PG8_SB(1, 1), b3 + hstepB, voffB); PG8_STAGE(PG8_SA(1, 0), a3, voffA);
            PG8_WAIT_V(8); PG8_WAIT_L(0); PG8_BAR; PG8_MMA(1, 0, At, B0); PG8_MMA(1, 1, At, B1); PG8_BAR; PG8_SCHED;
        }
        if (wr == 0) PG8_BAR;
        { int fr2 = fr, fq2 = fq; asm volatile("" : "+v"(fr2), "+v"(fq2)); E(acc, cur, wr, wc, fr2, fq2); }
        if (!has_next) break;
#pragma unroll
        for (int a = 0; a < 2; ++a)
#pragma unroll
            for (int b = 0; b < 2; ++b)
#pragma unroll
                for (int m = 0; m < 4; ++m)
#pragma unroll
                    for (int n = 0; n < 2; ++n) acc[a][b][m][n] = (f32x4){0.f, 0.f, 0.f, 0.f};
        cur = nxt; cA = nA; cB = nB; ++ui;
        if (wr == 1) PG8_BAR;
    }
    PG8_WAIT_V(0);
    PG8_BAR;
#undef PG8_SA
#undef PG8_SB
#undef PG8_STAGE
#undef PG8_LDA
#undef PG8_LDB
#undef PG8_MMA
#undef PG8_WAIT_V
#undef PG8_WAIT_L
#undef PG8_BAR
#undef PG8_SCHED
}
}
using pg8::Unit;
typedef f32x4 AccT[2][2][4][2];

#define EPI_ROWS_BEGIN _Pragma("unroll") for (int ai = 0; ai < 2; ++ai) _Pragma("unroll") for (int m = 0; m < 4; ++m) { const int row = u.pm * 256 + ai * 128 + wr * 64 + m * 16 + fr;
#define EPI_ROWS_END }
#define EPI_ROWS_END4 if (m == 3) asm volatile("" ::: "memory"); }
#define EPI_ROWS_END_NOFENCE }
#define EPI_LOAD_R(R) float rr8[2][4]; _Pragma("unroll") for (int ai = 0; ai < 2; ++ai) _Pragma("unroll") for (int m = 0; m < 4; ++m) rr8[ai][m] = (R)[u.pm * 256 + ai * 128 + wr * 64 + m * 16 + fr];
#define ACC8(dst, ai, bj, m) { const f32x4 _a = acc[ai][bj][m][0], _b = acc[ai][bj][m][1]; dst[0] = _a[0]; dst[1] = _a[1]; dst[2] = _a[2]; dst[3] = _a[3]; dst[4] = _b[0]; dst[5] = _b[1]; dst[6] = _b[2]; dst[7] = _b[3]; }

template <int MODE  > struct EpiPair {
    bf16_t* O; int ldo; const float* R; const float* BIAS;
    __device__ __forceinline__ void operator()(const AccT& acc, const Unit& u, int wr, int wc, int fr, int fq) const {
        const int col = u.pn * 128 + wc * 32 + 8 * fq;
        f32x4 ba0, ba1, bb0, bb1; float rr8[2][4];
        if (MODE == 0) {
            const int rt = u.pm * 256; const float* bp = BIAS + (rt < ML ? (rt >> 12) : 8) * 5632 + u.pn * 256 + wc * 32 + 8 * fq;
            ba0 = *(const f32x4*)bp; ba1 = *(const f32x4*)(bp + 4); bb0 = *(const f32x4*)(bp + 128); bb1 = *(const f32x4*)(bp + 132);
#pragma unroll
            for (int ai = 0; ai < 2; ++ai)
#pragma unroll
                for (int m = 0; m < 4; ++m) rr8[ai][m] = R[rt + ai * 128 + wr * 64 + m * 16 + fr];
        }
        EPI_ROWS_BEGIN
            float a[8], b[8], r[8]; ACC8(a, ai, 0, m); ACC8(b, ai, 1, m);
            if (MODE == 0) {
                const float rr = rr8[ai][m];
#pragma unroll
                for (int j = 0; j < 4; ++j) { a[j] = rr * a[j] + ba0[j]; a[4 + j] = rr * a[4 + j] + ba1[j]; b[j] = rr * b[j] + bb0[j]; b[4 + j] = rr * b[4 + j] + bb1[j]; }
            }
#pragma unroll
            for (int j = 0; j < 8; ++j) r[j] = MODE == 0 ? siluf_(a[j]) * b[j] : a[j] * sigmoidf_(b[j]);
            *(u32x4*)(O + (size_t)row * ldo + col) = pack8(r);
        EPI_ROWS_END
    }
};
template <bool SLICE, bool HALFSTEP> struct EpiRes {
    float* H; const float* gate; float* PART; const float* GS; bf16_t* AN; float* ROWSQ;
    __device__ __forceinline__ void operator()(const AccT& acc, const Unit& u, int wr, int wc, int fr, int fq) const {
        constexpr float sc = HALFSTEP ? 0.5f : 1.0f; constexpr int row0 = SLICE ? ML : 0;
        const int rt = row0 + u.pm * 256, bi = rt < ML ? (rt >> 12) : 8;
        f32x4 gq[2][2], sq[2][2];
#pragma unroll
        for (int bj = 0; bj < 2; ++bj) { const int col = u.pn * 256 + bj * 128 + wc * 32 + 8 * fq;
            const float* gp = gate + bi * NMOD + col; gq[bj][0] = *(const f32x4*)gp * sc; gq[bj][1] = *(const f32x4*)(gp + 4) * sc;
            if (!SLICE) { const float* gsp = GS + bi * DM + col; sq[bj][0] = *(const f32x4*)gsp; sq[bj][1] = *(const f32x4*)(gsp + 4); } }
        EPI_ROWS_BEGIN
            const int grow = row0 + row;
            float ss = 0.f;
#pragma unroll
            for (int bj = 0; bj < 2; ++bj) {
                const int col = u.pn * 256 + bj * 128 + wc * 32 + 8 * fq;
                float* p = H + (size_t)grow * DM + col;
                const f32x4 d0 = gq[bj][0] * acc[ai][bj][m][0], d1 = gq[bj][1] * acc[ai][bj][m][1];
                if (SLICE) {
                    float* pp = PART + ((size_t)u.z * MC + (grow - ML)) * DM + col;
                    *(f32x4*)pp = d0; *(f32x4*)(pp + 4) = d1;
                } else {
                    f32x4 h0 = *(const f32x4*)p, h1 = *(const f32x4*)(p + 4);
                    h0 += d0; h1 += d1;
                    *(f32x4*)p = h0; *(f32x4*)(p + 4) = h1;
                    ss += (h0[0] * h0[0] + h0[1] * h0[1]) + (h0[2] * h0[2] + h0[3] * h0[3]) + (h1[0] * h1[0] + h1[1] * h1[1]) + (h1[2] * h1[2] + h1[3] * h1[3]);
                    h0 *= sq[bj][0]; h1 *= sq[bj][1];
                    float r[8] = {h0[0], h0[1], h0[2], h0[3], h1[0], h1[1], h1[2], h1[3]};
                    *(u32x4*)(AN + (size_t)grow * DM + col) = pack8(r);
                }
            }
            if (!SLICE) { ss += __shfl_xor(ss, 16); ss += __shfl_xor(ss, 32); if (fq == 0) ROWSQ[(size_t)grow * 16 + u.pn * 4 + wc] = ss; }
        EPI_ROWS_END4
    }
};
struct EpiInT {
    bf16_t* VT2; bf16_t* VT2C; const float* R; const float* BIAS;
    __device__ __forceinline__ void operator()(const AccT& acc, const Unit& u, int wr, int wc, int fr, int fq) const {
        const int mt0 = u.pn * 256; const float* bb = BIAS + (mt0 < ML ? (mt0 >> 12) : 8) * 3584;
        f32x4 rr[2][2];
#pragma unroll
        for (int bj = 0; bj < 2; ++bj) { const float* rp = R + mt0 + bj * 128 + wc * 32 + 8 * fq; rr[bj][0] = *(const f32x4*)rp; rr[bj][1] = *(const f32x4*)(rp + 4); }
        EPI_LOAD_R(bb)
        EPI_ROWS_BEGIN
            const int grp = row >> 8, part = (row >> 7) & 1, ch = grp * 128 + (row & 127); const float bv = rr8[ai][m];
#pragma unroll
            for (int bj = 0; bj < 2; ++bj) {
                const int m0 = mt0 + bj * 128 + wc * 32 + 8 * fq;
                const f32x4 v0 = acc[ai][bj][m][0] * rr[bj][0] + bv, v1 = acc[ai][bj][m][1] * rr[bj][1] + bv;
                float r[8] = {v0[0], v0[1], v0[2], v0[3], v1[0], v1[1], v1[2], v1[3]};
                bf16_t* dst;
                if (m0 < ML) { const int b = m0 >> 12, t = m0 & 4095; dst = VT2 + ((size_t)(b * 512 + ch) * 8192 + part * 4096 + t); }
                else { const int mm = m0 - ML, b = mm >> 8, t = mm & 255; dst = VT2C + ((size_t)(b * 512 + ch) * 512 + part * 256 + t); }
                *(u32x4*)dst = pack8(r);
            }
        EPI_ROWS_END
    }
};
struct EpiInU {
    bf16_t* UG; const float* R; const float* BIAS;
    __device__ __forceinline__ void operator()(const AccT& acc, const Unit& u, int wr, int wc, int fr, int fq) const {
        const int rt = u.pm * 256; const float* bb = BIAS + (rt < ML ? (rt >> 12) : 8) * 3584 + 1024;
        f32x4 bq[2][2];
#pragma unroll
        for (int bj = 0; bj < 2; ++bj) { const int c = u.pn * 256 + bj * 128 + wc * 32 + 8 * fq; bq[bj][0] = *(const f32x4*)(bb + c); bq[bj][1] = *(const f32x4*)(bb + c + 4); }
        EPI_LOAD_R(R)
        EPI_ROWS_BEGIN
            int urow, ii;
            if (row < ML) { const int b = row >> 12, t = row & 4095; urow = b * 256 + (t >> 4); ii = t & 15; }
            else { const int mm = row - ML, b = mm >> 8, t = mm & 255; urow = 2048 + b * 16 + (t >> 4); ii = t & 15; }
            const float rr = rr8[ai][m];
#pragma unroll
            for (int bj = 0; bj < 2; ++bj) {
                const int c = u.pn * 256 + bj * 128 + wc * 32 + 8 * fq, g = c >> 4, h0 = c & 15;
                const f32x4 v0 = acc[ai][bj][m][0] * rr + bq[bj][0], v1 = acc[ai][bj][m][1] * rr + bq[bj][1];
                float r[8] = {v0[0], v0[1], v0[2], v0[3], v1[0], v1[1], v1[2], v1[3]};
                *(u32x4*)(UG + ((size_t)(g * UROWS + urow) * 256 + ii * 16 + h0)) = pack8(r);
            }
        EPI_ROWS_END
    }
};
struct EpiInG {
    bf16_t* SGF; bf16_t* SGS; const float* R; const float* BIAS;
    __device__ __forceinline__ void operator()(const AccT& acc, const Unit& u, int wr, int wc, int fr, int fq) const {
        bf16_t* base = u.pn < 4 ? SGF : SGS; const int c0 = (u.pn & 3) * 256 + wc * 32 + 8 * fq, cb = 1536 + u.pn * 256 + wc * 32 + 8 * fq;
        const int rt = u.pm * 256; const float* bb = BIAS + (rt < ML ? (rt >> 12) : 8) * 3584 + cb;
        f32x4 bq[2][2];
#pragma unroll
        for (int bj = 0; bj < 2; ++bj) { bq[bj][0] = *(const f32x4*)(bb + bj * 128); bq[bj][1] = *(const f32x4*)(bb + bj * 128 + 4); }
        EPI_LOAD_R(R)
        EPI_ROWS_BEGIN
            const float rr = rr8[ai][m];
#pragma unroll
            for (int bj = 0; bj < 2; ++bj) {
                const f32x4 v0 = acc[ai][bj][m][0] * rr + bq[bj][0], v1 = acc[ai][bj][m][1] * rr + bq[bj][1];
                float r[8] = {v0[0], v0[1], v0[2], v0[3], v1[0], v1[1], v1[2], v1[3]};
#pragma unroll
                for (int j = 0; j < 8; ++j) r[j] = sigmoidf_(r[j]);
                *(u32x4*)(base + (size_t)row * DM + c0 + bj * 128) = pack8(r);
            }
        EPI_ROWS_END
    }
};
struct EpiF2 {
    bf16_t* O; int rbase, zrows, ldo;
    __device__ __forceinline__ void operator()(const AccT& acc, const Unit& u, int wr, int wc, int fr, int fq) const {
        EPI_ROWS_BEGIN
            const size_t orow = (size_t)(rbase + u.z * zrows + row);
#pragma unroll
            for (int bj = 0; bj < 2; ++bj) { float r[8]; ACC8(r, ai, bj, m); *(u32x4*)(O + orow * ldo + u.pn * 256 + bj * 128 + wc * 32 + 8 * fq) = pack8(r); }
        EPI_ROWS_END
    }
};
struct EpiSsmA {
    bf16_t* YI; float* S;
    __device__ __forceinline__ void operator()(const AccT& acc, const Unit& u, int wr, int wc, int fr, int fq) const {
        EPI_ROWS_BEGIN
            const size_t base = ((size_t)u.z * UROWS + row) * 256;
#pragma unroll
            for (int bj = 0; bj < 2; ++bj) {
                const int col = bj * 128 + wc * 32 + 8 * fq;
                if (u.pn == 0) { float r[8]; ACC8(r, ai, bj, m); *(u32x4*)(YI + base + col) = pack8(r); }
                else { *(f32x4*)(S + base + col) = acc[ai][bj][m][0]; *(f32x4*)(S + base + col + 4) = acc[ai][bj][m][1]; }
            }
        EPI_ROWS_END
    }
};
struct EpiSsmB {
    const bf16_t* YI; bf16_t* YS;
    __device__ __forceinline__ void operator()(const AccT& acc, const Unit& u, int wr, int wc, int fr, int fq) const {
        EPI_ROWS_BEGIN
            int tok0;
            if (row < 2048) tok0 = (row >> 8) * 4096 + (row & 255) * 16;
            else { const int rr = row - 2048; tok0 = ML + (rr >> 4) * 256 + (rr & 15) * 16; }
            if (row < 2176) {
                const size_t base = ((size_t)u.z * UROWS + row) * 256;
#pragma unroll
                for (int bj = 0; bj < 2; ++bj) {
                    const int col = bj * 128 + wc * 32 + 8 * fq, j = col >> 4, h0 = col & 15;
                    float r[8], yi[8]; ACC8(r, ai, bj, m); unpack8(*(const u32x4*)(YI + base + col), yi);
#pragma unroll
                    for (int q = 0; q < 8; ++q) r[q] = gelu_tanh(r[q] + yi[q]);
                    *(u32x4*)(YS + (size_t)(tok0 + j) * 512 + u.z * 16 + h0) = pack8(r);
                }
            }
        EPI_ROWS_END_NOFENCE
    }
};
struct EpiFo {
    bf16_t* SGF;
    __device__ __forceinline__ void operator()(const AccT& acc, const Unit& u, int wr, int wc, int fr, int fq) const {
        EPI_ROWS_BEGIN
#pragma unroll
            for (int bj = 0; bj < 2; ++bj) {
                bf16_t* p = SGF + (size_t)row * DM + u.pn * 256 + bj * 128 + wc * 32 + 8 * fq;
                float r[8], g[8]; ACC8(r, ai, bj, m); unpack8(*(const u32x4*)p, g);
#pragma unroll
                for (int q = 0; q < 8; ++q) r[q] *= g[q];
                *(u32x4*)p = pack8(r);
            }
        EPI_ROWS_END_NOFENCE
    }
};
struct EpiSso {
    bf16_t* SGS; const bf16_t* MG1;
    __device__ __forceinline__ void operator()(const AccT& acc, const Unit& u, int wr, int wc, int fr, int fq) const {
        EPI_ROWS_BEGIN
#pragma unroll
            for (int bj = 0; bj < 2; ++bj) {
                const size_t off = (size_t)row * DM + u.pn * 256 + bj * 128 + wc * 32 + 8 * fq;
                float r[8], g[8], f[8]; ACC8(r, ai, bj, m); unpack8(*(const u32x4*)(SGS + off), g); unpack8(*(const u32x4*)(MG1 + off), f);
#pragma unroll
                for (int q = 0; q < 8; ++q) r[q] = f[q] + g[q] * r[q];
                *(u32x4*)(SGS + off) = pack8(r);
            }
        EPI_ROWS_END_NOFENCE
    }
};

struct Ctx { LAS unsigned char* lds; int tid, lane, wave, G, bid, gw, NGW; };
#define SUBCTX(Cs, lo, n) Ctx Cs = C; { int _b = C.bid - (lo); if (_b < 0) _b += C.G; Cs.bid = _b; Cs.G = (n); Cs.gw = _b * 8 + C.wave; Cs.NGW = (n) * 8; }
#define CTX_REFRESH(C) do { int _t = ((C).wave << 6) | (int)__builtin_amdgcn_mbcnt_hi(~0u, __builtin_amdgcn_mbcnt_lo(~0u, 0u)); asm volatile("" : "+v"(_t)); (C).tid = _t; (C).lane = _t & 63; int _g = (C).gw; asm volatile("" : "+s"(_g)); (C).gw = _g; } while (0)

__device__ __forceinline__ void transpose_item(const Ctx& C, const float* W, int K, int ldw, int n0, int ncols, bf16_t* WT, int mode, int half, int row_off, int item) {
    LAS float* scr = (LAS float*)(C.lds + C.wave * 16384);
    const int nblk = ncols / 32, kb = item / nblk, nb = item % nblk, k0 = 64 * kb, nr0 = 32 * nb, lane = C.lane;
    int r0;
    if (mode == 0) r0 = row_off + nr0;
    else { const int hsel = nr0 >= half ? 1 : 0, j = nr0 - hsel * half; r0 = (j >> 7) * 256 + hsel * 128 + (j & 127); }
    float tv[32];
#pragma unroll
    for (int i = 0; i < 32; ++i) tv[i] = W[(size_t)(k0 + 2 * i + (lane >> 5)) * ldw + n0 + nr0 + (lane & 31)];
#pragma unroll
    for (int i = 0; i < 32; ++i) { const int kk = 2 * i + (lane >> 5); scr[kk * 33 + (lane & 31)] = tv[i]; }
    asm volatile("s_waitcnt lgkmcnt(0)" ::: "memory");
    const int c = lane & 7;
#pragma unroll
    for (int j = 0; j < 4; ++j) { const int n = (lane >> 3) + 8 * j; const LAS float* s = scr + (8 * c) * 33 + n;
        u32x4 o; o.x = cvt_pk_bf16(s[0 * 33], s[1 * 33]); o.y = cvt_pk_bf16(s[2 * 33], s[3 * 33]); o.z = cvt_pk_bf16(s[4 * 33], s[5 * 33]); o.w = cvt_pk_bf16(s[6 * 33], s[7 * 33]);
        *(u32x4*)(WT + (size_t)(r0 + n) * K + k0 + 8 * c) = o; }
    asm volatile("s_waitcnt lgkmcnt(0)" ::: "memory");
}
__device__ __forceinline__ void prep_transposes(const Ctx& C, const float* w13, const float* w2, const float* win, const float* wfo, const float* wglu, const float* wsso, const float* wout,
                                                bf16_t* W13, bf16_t* W2, bf16_t* WIN, bf16_t* WFO, bf16_t* WGLU, bf16_t* WSSO, bf16_t* WOUT, const bool with_ffn) {
    const int I0 = with_ffn ? 16 * 176 : 0, I1 = with_ffn ? 44 * 32 : 0; constexpr int I2 = 16 * 80, I3 = 8 * 32, I4 = 8 * 32, I5 = 8 * 32, I6 = 16 * 32; const int TOT = I0 + I1 + I2 + I3 + I4 + I5 + I6;
    int vb = C.bid; if (vb >= 128 && vb < 160) return; if (vb >= 160) vb -= 32;
    const int nvw = (C.G - 32) * 8;
    for (int it = vb * 8 + C.wave; it < TOT; it += nvw) {
        int r = it;
        if (r < I0) { transpose_item(C, w13, 1024, 5632, 0, 5632, W13, 1, 2816, 0, r); continue; } r -= I0;
        if (r < I1) { transpose_item(C, w2, 2816, 1024, 0, 1024, W2, 0, 0, 0, r); continue; } r -= I1;
        if (r < I2) { transpose_item(C, win, 1024, 3072, 512, 2560, WIN, 0, 0, 1024, r); continue; } r -= I2;
        if (r < I3) { transpose_item(C, wfo, 512, 1024, 0, 1024, WFO, 0, 0, 0, r); continue; } r -= I3;
        if (r < I4) { transpose_item(C, wglu, 512, 1024, 0, 1024, WGLU, 1, 512, 0, r); continue; } r -= I4;
        if (r < I5) { transpose_item(C, wsso, 512, 1024, 0, 1024, WSSO, 0, 0, 0, r); continue; } r -= I5;
        transpose_item(C, wout, 1024, 1024, 0, 1024, WOUT, 0, 0, 0, r);
    }
}
__device__ __forceinline__ void transpose_mat(const Ctx& C, const float* W, int K, int ldw, int n0, int ncols, bf16_t* WT, int mode, int half, int row_off) {
    const int items = (K / 64) * (ncols / 32);
    for (int it = C.gw; it < items; it += C.NGW) transpose_item(C, W, K, ldw, n0, ncols, WT, mode, half, row_off, it);
}

__device__ __forceinline__ void fourier_weight_phase(const Ctx& C, const float* Win  , bf16_t* WT) {
    LAS float* Wl = (LAS float*)C.lds; LAS float* ct = Wl + 16 * 129; LAS float* st = ct + 128;
    for (int it = C.bid; it < 256; it += C.G) {
        const int grp = it >> 6, k0 = (it & 63) * 16;
        for (int e = C.tid; e < 16 * 128; e += 512) { const int k = e >> 7, c = e & 127; Wl[k * 129 + c] = Win[(size_t)(k0 + k) * 3072 + grp * 128 + c]; }
        if (C.tid < 128) { float sn, cs; sincosf(6.283185307179586f * (float)C.tid * (1.f / 128.f), &sn, &cs); ct[C.tid] = cs; st[C.tid] = sn; }
        __syncthreads();
        if (C.tid < 256) {
            const int kq = C.tid & 3, nq = C.tid >> 2, n0 = nq * 4, part = n0 >> 7, j0 = n0 & 127; const LAS float* tb = part ? st : ct;
            float a[4][4];
#pragma unroll
            for (int x = 0; x < 4; ++x)
#pragma unroll
                for (int y = 0; y < 4; ++y) a[x][y] = 0.f;
            for (int c = 0; c < 128; ++c) {
                float w[4], t[4];
#pragma unroll
                for (int x = 0; x < 4; ++x) w[x] = Wl[(kq * 4 + x) * 129 + c];
#pragma unroll
                for (int y = 0; y < 4; ++y) t[y] = tb[(c * (j0 + y)) & 127];
#pragma unroll
                for (int x = 0; x < 4; ++x)
#pragma unroll
                    for (int y = 0; y < 4; ++y) a[x][y] += w[x] * t[y];
            }
#pragma unroll
            for (int y = 0; y < 4; ++y) {
                u32x2 o; o.x = cvt_pk_bf16(a[0][y] * 0.08838834764831845f, a[1][y] * 0.08838834764831845f); o.y = cvt_pk_bf16(a[2][y] * 0.08838834764831845f, a[3][y] * 0.08838834764831845f);
                *(u32x2*)(WT + (size_t)(grp * 256 + n0 + y) * 1024 + k0 + kq * 4) = o;
            }
        }
        __syncthreads();
    }
}

struct SsmP { const float *lre, *lim, *lst, *bre, *bim, *cre, *cim, *dd; };
__device__ __forceinline__ void ssm_mats_phase(const Ctx& C, const SsmP& P, bf16_t* Wa, bf16_t* Wb) {
    LAS float* LP = (LAS float*)C.lds;
    LAS float* BB = LP + 2 * 17 * 64 * 2;
    LAS float* CC = BB + 2 * 64 * 16 * 2;
    LAS float* KK = CC + 2 * 16 * 64 * 2;
    const int tid = C.tid;
    for (int g = (C.bid + C.G - 128) % C.G; g < 32; g += C.G) {
        LAS float* KC = KK;
        if (tid < 128) {
            const int d = tid >> 6, p = tid & 63;
            const float dt = expf(P.lst[d * 32 + g]); const float lr = P.lre[(d * 32 + g) * 64 + p], li = P.lim[(d * 32 + g) * 64 + p];
            const float mag = expf(lr * dt); float sn, cs; sincosf(li * dt, &sn, &cs);
            const float l1r = mag * cs, l1i = mag * sn;
            float pr = 1.f, pi = 0.f;
            for (int t = 0; t <= 16; ++t) { LP[((d * 17 + t) * 64 + p) * 2] = pr; LP[((d * 17 + t) * 64 + p) * 2 + 1] = pi;
                const float nr_ = pr * l1r - pi * l1i, ni_ = pr * l1i + pi * l1r; pr = nr_; pi = ni_; }
            const float nr = l1r - 1.f, ni = l1i, den = lr * lr + li * li;
            KC[(d * 64 + p) * 2] = (nr * lr + ni * li) / den; KC[(d * 64 + p) * 2 + 1] = (ni * lr - nr * li) / den;
        }
        float brv[4], biv[4];
#pragma unroll
        for (int q = 0; q < 4; ++q) { const int e = tid + 512 * q, d = e >> 10; const size_t gi = (size_t)(d * 32 + g) * 1024 + (e & 1023);
            brv[q] = P.bre[gi]; biv[q] = P.bim[gi];
            const int h = (e >> 6) & 15, p = e & 63; CC[((d * 64 + p) * 16 + h) * 2] = P.cre[gi]; CC[((d * 64 + p) * 16 + h) * 2 + 1] = P.cim[gi]; }
        __syncthreads();
#pragma unroll
        for (int q = 0; q < 4; ++q) { const int e = tid + 512 * q, d = e >> 10, p = (e >> 4) & 63, h = e & 15;
            const float kr = KC[(d * 64 + p) * 2], ki = KC[(d * 64 + p) * 2 + 1];
            BB[((d * 64 + p) * 16 + h) * 2] = kr * brv[q] - ki * biv[q]; BB[((d * 64 + p) * 16 + h) * 2 + 1] = kr * biv[q] + ki * brv[q]; }
        __syncthreads();
        {
            const int d = tid >> 8, t = (tid >> 4) & 15, h = tid & 15;
            float a[16];
#pragma unroll
            for (int q = 0; q < 16; ++q) a[q] = 0.f;
            for (int p = 0; p < 64; ++p) {
                const float cr = CC[((d * 64 + p) * 16 + h) * 2], ci = CC[((d * 64 + p) * 16 + h) * 2 + 1];
                const float Lr = LP[((d * 17 + t) * 64 + p) * 2], Li = LP[((d * 17 + t) * 64 + p) * 2 + 1];
                const float gr = cr * Lr - ci * Li, gi = cr * Li + ci * Lr;
#pragma unroll
                for (int q = 0; q < 16; ++q) a[q] += gr * BB[((d * 64 + p) * 16 + q) * 2] - gi * BB[((d * 64 + p) * 16 + q) * 2 + 1];
            }
#pragma unroll
            for (int q = 0; q < 16; ++q) KK[((d * 16 + t) * 16 + h) * 16 + q] = a[q];
        }
        __syncthreads();
        bf16_t* wa = Wa + (size_t)g * 512 * 256;
        for (int v = tid; v < 512 * 32; v += 512) {
            const int n = v >> 5, kv = (v & 31) * 8, i = kv >> 4, hp0 = kv & 15;
            float r[8];
            if (n < 256) {
                const int j = n >> 4, h = n & 15;
#pragma unroll
                for (int q = 0; q < 8; ++q) { const int hp = hp0 + q; float x = 0.f;
                    if (j >= i) x += KK[((0 * 16 + (j - i)) * 16 + h) * 16 + hp];
                    if (i >= j) x += KK[((1 * 16 + (i - j)) * 16 + h) * 16 + hp];
                    if (i == j && h == hp) x += P.dd[g * 16 + h];
                    r[q] = x; }
            } else {
                const int qn = n - 256, d = qn >> 7, ri = (qn >> 6) & 1, p = qn & 63, t = d == 0 ? 15 - i : i;
                const float Lr = LP[((d * 17 + t) * 64 + p) * 2], Li = LP[((d * 17 + t) * 64 + p) * 2 + 1];
#pragma unroll
                for (int q = 0; q < 8; ++q) { const int hp = hp0 + q; const float br = BB[((d * 64 + p) * 16 + hp) * 2], bi = BB[((d * 64 + p) * 16 + hp) * 2 + 1];
                    r[q] = ri ? (Lr * bi + Li * br) : (Lr * br - Li * bi); }
            }
            *(u32x4*)(wa + (size_t)n * 256 + kv) = pack8(r);
        }
        bf16_t* wb = Wb + (size_t)g * 256 * 256;
        for (int v = tid; v < 256 * 32; v += 512) {
            const int n = v >> 5, kv = (v & 31) * 8, j = n >> 4, h = n & 15, d = kv >> 7, ri = (kv >> 6) & 1, p0 = kv & 63, e = d == 0 ? j + 1 : 16 - j;
            float r[8];
#pragma unroll
            for (int q = 0; q < 8; ++q) { const int p = p0 + q;
                const float cr = CC[((d * 64 + p) * 16 + h) * 2], ci = CC[((d * 64 + p) * 16 + h) * 2 + 1];
                const float Lr = LP[((d * 17 + e) * 64 + p) * 2], Li = LP[((d * 17 + e) * 64 + p) * 2 + 1];
                r[q] = ri ? -(cr * Li + ci * Lr) : (cr * Lr - ci * Li); }
            *(u32x4*)(wb + (size_t)n * 256 + kv) = pack8(r);
        }
        __syncthreads();
    }
}

__device__ __forceinline__ void ssm_scan_phase(const Ctx& C, const SsmP& P, const float* S, bf16_t* Hin) {
    for (int it = C.bid; it < 256; it += C.G) {
        const int g = it >> 3, b = it & 7;
        if (C.tid < 128) {
            const int d = C.tid >> 6, p = C.tid & 63;
            const float dt = expf(P.lst[d * 32 + g]); const float lr = P.lre[(d * 32 + g) * 64 + p], li = P.lim[(d * 32 + g) * 64 + p];
            const float mag = expf(lr * dt * 16.f); float sn, cs; sincosf(li * dt * 16.f, &sn, &cs);
            const float Ar = mag * cs, Ai = mag * sn;
            float hr = 0.f, hi = 0.f;
            const float* Sg = S + (size_t)g * UROWS * 256 + d * 128 + p; bf16_t* Hg = Hin + (size_t)g * UROWS * 256 + d * 128 + p;
            float sr[16], si[16], nr_[16], ni_[16];
            {   const int rowb = 2048 + b * 16 + (d ? 15 : 0), dir = d ? -1 : 1;
#pragma unroll
                for (int q = 0; q < 16; ++q) { const size_t o = (size_t)(rowb + dir * q) * 256; sr[q] = Sg[o]; si[q] = Sg[o + 64]; } }
            for (int s0 = 0; s0 < 272; s0 += 16) {
                const int dir = d ? -1 : 1;
                const int rowb = s0 == 0 ? 2048 + b * 16 + (d ? 15 : 0) : b * 256 + (d ? 271 - s0 : s0 - 16);
                const int s1 = s0 + 16 < 272 ? s0 + 16 : s0;
                const int rown = b * 256 + (d ? 271 - s1 : s1 - 16);
#pragma unroll
                for (int q = 0; q < 16; ++q) { const size_t o = (size_t)(rown + dir * q) * 256; nr_[q] = Sg[o]; ni_[q] = Sg[o + 64]; }
#pragma unroll
                for (int q = 0; q < 16; ++q) { const size_t o = (size_t)(rowb + dir * q) * 256;
                    const unsigned pk = cvt_pk_bf16(hr, hi); Hg[o] = (bf16_t)(pk & 0xffffu); Hg[o + 64] = (bf16_t)(pk >> 16);
                    const float nr = Ar * hr - Ai * hi + sr[q], ni = Ar * hi + Ai * hr + si[q]; hr = nr; hi = ni; }
#pragma unroll
                for (int q = 0; q < 16; ++q) { sr[q] = nr_[q]; si[q] = ni_[q]; }
            }
        }
    }
}

__device__ __forceinline__ void mod_partial_phase(const Ctx& C, const float* cvec, const float* cctx, const float* wmod, float* MODP) {
    LAS float* cvs = (LAS float*)C.lds;
    for (int it = C.bid; it < 4 * 18 * 16; it += C.G) {
        const int l = it / 288, rem = it % 288, nb = rem >> 4, kc = rem & 15;
        __syncthreads();
        for (int e = C.tid; e < 576; e += 512) { const int r = e >> 6, k = e & 63; const float v = r < 8 ? cvec[r * 1024 + kc * 64 + k] : cctx[kc * 64 + k]; cvs[e] = v / (1.f + expf(-v)); }
        __syncthreads();
        const int n = nb * 512 + C.tid;
        float a[9];
#pragma unroll
        for (int r = 0; r < 9; ++r) a[r] = 0.f;
        const float* wp = wmod + ((size_t)l * 1024 + kc * 64) * NMOD + n;
        float wv[64];
#pragma unroll
        for (int k = 0; k < 64; ++k) wv[k] = wp[(size_t)k * NMOD];
#pragma unroll
        for (int k = 0; k < 64; ++k) {
#pragma unroll
            for (int r = 0; r < 9; ++r) a[r] += cvs[r * 64 + k] * wv[k]; }
#pragma unroll
        for (int r = 0; r < 9; ++r) MODP[((size_t)(kc * 4 + l) * 9 + r) * NMOD + n] = a[r];
    }
}
__device__ __forceinline__ void mod_final_phase(const Ctx& C, const float* bmod, const float* normg, const float* MODP, float* MOD, float* GS) {
    for (int e = C.bid * 512 + C.tid; e < 4 * 9 * NMOD; e += C.G * 512) {
        const int l = e / (9 * NMOD), r = (e / NMOD) % 9, n = e % NMOD; float a = bmod[l * NMOD + n];
#pragma unroll
        for (int kc = 0; kc < 16; ++kc) a += MODP[(size_t)kc * (4 * 9 * NMOD) + e];
        MOD[e] = a;
        const int j = n >> 10, c = n & 1023;
        if (j % 3 == 1) { const int k = j / 3; GS[((size_t)(l * 3 + k) * 9 + r) * DM + c] = normg[(l * 3 + k) * DM + c] * (1.f + a); }
    }
}
__device__ __forceinline__ void dft_gen_phase(const Ctx& C, bf16_t* DFT, bf16_t* DFTC) {
    LAS float* tab = (LAS float*)C.lds;
    __syncthreads();
    for (int i = C.tid; i < 4096; i += 512) tab[i] = cosf(6.283185307179586f * (float)i * (1.f / 4096.f));
    __syncthreads();
    const size_t nv = (size_t)4096 * 4096 / 8;
    for (size_t v = (size_t)C.bid * 512 + C.tid; v < nv; v += (size_t)C.G * 512) {
        const int r_ = (int)(v >> 9), t0 = (int)(v & 511) * 8, k = r_ & 2047, isq = r_ >> 11;
        float r[8];
#pragma unroll
        for (int q = 0; q < 8; ++q) { const int idx = (k * (t0 + q)) & 4095; r[q] = (isq ? tab[(idx - 1024) & 4095] : tab[idx]) * (1.f / 64.f); }
        *(u32x4*)(DFT + v * 8) = pack8(r);
    }
    for (int v = C.bid * 512 + C.tid; v < 256 * 512 / 8; v += C.G * 512) {
        const int k = v >> 6, kk0 = (v & 63) * 8, part = kk0 >> 8, t0 = kk0 & 255;
        float r[8];
#pragma unroll
        for (int q = 0; q < 8; ++q) { const int idx = ((k * (t0 + q)) & 255) * 16; r[q] = (part ? -tab[(idx - 1024) & 4095] : tab[idx]) * (1.f / 16.f); }
        *(u32x4*)(DFTC + (size_t)v * 8) = pack8(r);
    }
}
__device__ __forceinline__ void f2_combine_phase(const Ctx& C, const bf16_t* PQ, const bf16_t* VT2, bf16_t* YF) {
    const int nv = 8 * 2048 * 64;
    for (int v = C.bid * 512 + C.tid; v < nv; v += C.G * 512) {
        const int b = v >> 17, k = (v >> 6) & 2047, c8 = (v & 63) * 8;
        float p[8], q[8], d[8], a[8];
        unpack8(*(const u32x4*)(PQ + ((size_t)b * 4096 + k) * 512 + c8), p); unpack8(*(const u32x4*)(PQ + ((size_t)b * 4096 + 2048 + k) * 512 + c8), q);
#pragma unroll
        for (int j = 0; j < 8; ++j) { d[j] = p[j] - q[j]; a[j] = p[j] + q[j]; }
        *(u32x4*)(YF + ((size_t)b * 4096 + k) * 512 + c8) = pack8(d);
        if (k > 0) *(u32x4*)(YF + ((size_t)b * 4096 + 4096 - k) * 512 + c8) = pack8(a);
    }
    for (int pr = C.gw; pr < 8 * 512; pr += C.NGW) {
        const int b = pr >> 9, ch = pr & 511;
        const u32x4* vp = (const u32x4*)(VT2 + (size_t)(b * 512 + ch) * 8192 + C.lane * 64);
        float s = 0.f;
#pragma unroll
        for (int i = 0; i < 8; ++i) { float w[8]; unpack8(vp[i], w); s += (w[0] - w[1]) + (w[2] - w[3]) + (w[4] - w[5]) + (w[6] - w[7]); }
        s = wave_sum(s);
        if (C.lane == 0) { const unsigned pk = cvt_pk_bf16(s * (1.f / 64.f), 0.f); YF[((size_t)b * 4096 + 2048) * 512 + ch] = (bf16_t)(pk & 0xffffu); }
    }
}
__device__ __forceinline__ void fin_rows_phase(const Ctx& C, float* H, const float* GSk, bf16_t* AN, const float* PART, int nslice, const float* ROWSQ, float* R, bool all_rows, const float* xin = nullptr, const float* cin = nullptr) {
    for (int m = (all_rows ? 0 : ML) + C.gw; m < MT; m += C.NGW) {
        const int bi = m < ML ? (m >> 12) : 8;
        f32x4* xr = (f32x4*)(H + (size_t)m * DM) + C.lane;
        f32x4 v[4]; float s = 0.f;
        if (all_rows) {
            const f32x4* ir = (const f32x4*)(m < ML ? xin + (size_t)m * DM : cin + (size_t)(m - ML) * DM) + C.lane;
#pragma unroll
            for (int j = 0; j < 4; ++j) { v[j] = ir[64 * j]; xr[64 * j] = v[j]; }
        } else {
#pragma unroll
            for (int j = 0; j < 4; ++j) v[j] = xr[64 * j];
        }
        if (!all_rows) {
            f32x4 pv[4][4];
#pragma unroll
            for (int z = 0; z < 4; ++z) { const f32x4* pr = (const f32x4*)(PART + ((size_t)(z < nslice ? z : 0) * MC + (m - ML)) * DM) + C.lane;
#pragma unroll
                for (int j = 0; j < 4; ++j) pv[z][j] = pr[64 * j]; }
#pragma unroll
            for (int z = 0; z < 4; ++z) if (z < nslice) {
#pragma unroll
                for (int j = 0; j < 4; ++j) v[j] += pv[z][j]; }
#pragma unroll
            for (int j = 0; j < 4; ++j) xr[64 * j] = v[j];
        }
#pragma unroll
        for (int j = 0; j < 4; ++j) s += (v[j][0] * v[j][0] + v[j][1] * v[j][1]) + (v[j][2] * v[j][2] + v[j][3] * v[j][3]);
        s = wave_sum(s);
        if (C.lane == 0) R[m] = rsqrtf(s * (1.f / 1024.f) + 1e-6f);
#pragma unroll
        for (int j = 0; j < 4; ++j) { const int c = 4 * (C.lane + 64 * j);
            const f32x4 y = v[j] * *(const f32x4*)(GSk + bi * DM + c);
            u32x2 w; w.x = cvt_pk_bf16(y[0], y[1]); w.y = cvt_pk_bf16(y[2], y[3]);
            *(u32x2*)(AN + (size_t)m * DM + c) = w; }
    }
    if (!all_rows)
        for (int m = C.bid * 512 + C.tid; m < ML; m += C.G * 512) {
            const f32x4* q = (const f32x4*)(ROWSQ + (size_t)m * 16); const f32x4 a = q[0], b = q[1], c = q[2], d = q[3];
            const float s = ((a[0] + a[1]) + (a[2] + a[3])) + ((b[0] + b[1]) + (b[2] + b[3])) + ((c[0] + c[1]) + (c[2] + c[3])) + ((d[0] + d[1]) + (d[2] + d[3]));
            R[m] = rsqrtf(s * (1.f / 1024.f) + 1e-6f);
        }
}
__device__ __forceinline__ void bias_phase(const Ctx& C, const bf16_t* Wt, int nrows, const float* shift  , float* BIAS) {
    for (int n = C.gw; n < nrows; n += C.NGW) {
        const u32x4* wp = (const u32x4*)(Wt + (size_t)n * DM + C.lane * 16);
        float w[16]; { float t0[8], t1[8]; unpack8(wp[0], t0); unpack8(wp[1], t1);
#pragma unroll
            for (int q = 0; q < 8; ++q) { w[q] = t0[q]; w[8 + q] = t1[q]; } }
        float a[9];
#pragma unroll
        for (int bi = 0; bi < 9; ++bi) {
            const f32x4* sp = (const f32x4*)(shift + bi * NMOD + C.lane * 16);
            float acc = 0.f;
#pragma unroll
            for (int q = 0; q < 4; ++q) { const f32x4 sv = sp[q]; acc += (sv[0] * w[4 * q] + sv[1] * w[4 * q + 1]) + (sv[2] * w[4 * q + 2] + sv[3] * w[4 * q + 3]); }
            a[bi] = acc;
        }
#pragma unroll
        for (int o = 1; o < 64; o <<= 1)
#pragma unroll
            for (int bi = 0; bi < 9; ++bi) a[bi] += __shfl_xor(a[bi], o);
        if (C.lane == 0) {
#pragma unroll
            for (int bi = 0; bi < 9; ++bi) BIAS[bi * nrows + n] = a[bi];
        }
    }
}
__device__ __forceinline__ void final_norm_phase(const Ctx& C, const float* H, const float* gvec, float* out) {
    for (int m = 2 * C.gw; m < ML; m += 2 * C.NGW) {
        const f32x4* xr0 = (const f32x4*)(H + (size_t)m * DM) + C.lane; const f32x4* xr1 = xr0 + DM / 4;
        f32x4 v0[4], v1[4]; float s0 = 0.f, s1 = 0.f;
#pragma unroll
        for (int j = 0; j < 4; ++j) { v0[j] = xr0[64 * j]; v1[j] = xr1[64 * j]; }
#pragma unroll
        for (int j = 0; j < 4; ++j) { s0 += (v0[j][0] * v0[j][0] + v0[j][1] * v0[j][1]) + (v0[j][2] * v0[j][2] + v0[j][3] * v0[j][3]);
                                      s1 += (v1[j][0] * v1[j][0] + v1[j][1] * v1[j][1]) + (v1[j][2] * v1[j][2] + v1[j][3] * v1[j][3]); }
#pragma unroll
        for (int o = 1; o < 64; o <<= 1) { s0 += __shfl_xor(s0, o); s1 += __shfl_xor(s1, o); }
        const float r0 = rsqrtf(s0 * (1.f / 1024.f) + 1e-6f), r1 = rsqrtf(s1 * (1.f / 1024.f) + 1e-6f);
#pragma unroll
        for (int j = 0; j < 4; ++j) { const int c = 4 * (C.lane + 64 * j); const f32x4 g4 = *(const f32x4*)(gvec + c);
            *(f32x4*)(out + (size_t)m * DM + c) = v0[j] * r0 * g4; *(f32x4*)(out + (size_t)(m + 1) * DM + c) = v1[j] * r1 * g4; }
    }
}

__device__ __forceinline__ void dump_phase(const Ctx& C, const bf16_t* a, const bf16_t* b, float* out) {
    const size_t n = (size_t)ML * 512;
    for (size_t i = (size_t)C.bid * 512 + C.tid; i < n; i += (size_t)C.G * 512) { out[i] = __uint_as_float((unsigned)a[i] << 16); out[n + i] = __uint_as_float((unsigned)b[i] << 16); }
}

#define XB_TMO      128
#define XB_XCNT(j)  (256  + 64 * (j))
#define XB_XSUB(j)  (1280 + 64 * (j))
#define XB_XGEN(j)  (2304 + 64 * (j))
#define XB_TOP      3328
#define XB_TOPGEN   3392
#define XCD_BAR_WORDS 3456
#define XB_SPIN_CAP (1u << 18)
__device__ __forceinline__ unsigned xb_ld(unsigned* p)              { return __hip_atomic_load(p, __ATOMIC_RELAXED, __HIP_MEMORY_SCOPE_AGENT); }
__device__ __forceinline__ unsigned xb_add(unsigned* p, unsigned v) { return __hip_atomic_fetch_add(p, v, __ATOMIC_RELAXED, __HIP_MEMORY_SCOPE_AGENT); }
__device__ __forceinline__ unsigned xb_xcc_id() { return (unsigned)__builtin_amdgcn_s_getreg((3 << 11) | 20) & 0xFu; }
#define XB_SPIN(cond, bar) do { unsigned _sp = 0; while (cond) { __builtin_amdgcn_s_sleep(1); \
    if ((++_sp & 255u) == 0u) { if (xb_ld(&(bar)[XB_TMO])) break; if (_sp > XB_SPIN_CAP) { atomicAdd(&(bar)[XB_TMO], 1u); break; } } } } while (0)
struct XcdBarrier { unsigned* bar; unsigned x; volatile LAS unsigned* st; };
__device__ __forceinline__ void xcd_barrier_complete(unsigned* bar, unsigned x, unsigned& nloc, unsigned& nx) {
    const unsigned G = gridDim.x * gridDim.y * gridDim.z;
    unsigned sum, cnt, mine, sp = 0u;
    for (;;) {
        sum = 0u; cnt = 0u; mine = 0u;
#pragma unroll
        for (unsigned j = 0; j < 16; ++j) { const unsigned c = xb_ld(&bar[XB_XCNT(j)]); sum += c; cnt += (c > 0u) ? 1u : 0u; mine = (j == x) ? c : mine; }
        if (sum == G) break;
        __builtin_amdgcn_s_sleep(1);
        if ((++sp & 255u) == 0u) { if (xb_ld(&bar[XB_TMO])) break; if (sp > XB_SPIN_CAP) { atomicAdd(&bar[XB_TMO], 1u); break; } }
    }
    nloc = mine > 0u ? mine : 1u; nx = cnt > 0u ? cnt : 1u;
}
__device__ __forceinline__ void xcd_barrier(const XcdBarrier& b) {
    asm volatile("s_waitcnt vmcnt(0)" ::: "memory");
    __syncthreads();
    if (threadIdx.x == 0) {
        unsigned* bar = b.bar;
        __builtin_amdgcn_s_waitcnt(0);
        unsigned nloc = b.st[0], nx = b.st[1];
        if (nloc == 0u) { xcd_barrier_complete(bar, b.x, nloc, nx); b.st[0] = nloc; b.st[1] = nx; }
        const unsigned old = xb_add(&bar[XB_XSUB(b.x)], 1u);
        const unsigned gen = old / nloc;
        if (old + 1u == (gen + 1u) * nloc) {
            __builtin_amdgcn_fence(__ATOMIC_RELEASE, "agent");
            asm volatile("s_waitcnt vmcnt(0)" ::: "memory");
            const unsigned og = xb_add(&bar[XB_TOP], 1u);
            const unsigned tg = og / nx;
            if (og + 1u == (tg + 1u) * nx) xb_add(&bar[XB_TOPGEN], 1u);
            else XB_SPIN(xb_ld(&bar[XB_TOPGEN]) == tg, bar);
            __builtin_amdgcn_fence(__ATOMIC_ACQUIRE, "agent");
            xb_add(&bar[XB_XGEN(b.x)], 1u);
            asm volatile("s_waitcnt vmcnt(0)" ::: "memory");
        } else {
            XB_SPIN(xb_ld(&bar[XB_XGEN(b.x)]) == gen, bar);
            __builtin_amdgcn_fence(__ATOMIC_ACQUIRE, "agent");
            asm volatile("s_waitcnt vmcnt(0)" ::: "memory");
        }
    }
    __syncthreads();
}
#ifndef PROF_SEL
#define PROF_SEL 0
#endif
#define PROF_TS ((volatile LAS unsigned long long*)(C.lds + 131072 + 1024))
#define PROF_CNT ((volatile LAS unsigned*)(C.lds + 131072 + 768))
#define PROF_STAMP() do { if (PROF_SEL && blockIdx.x == 0 && threadIdx.x == 0) { const unsigned _n = PROF_CNT[0]; PROF_TS[_n] = __builtin_amdgcn_s_memrealtime(); PROF_CNT[0] = _n + 1; } } while (0)
#define GRID_SYNC_CG() do { asm volatile("s_waitcnt vmcnt(0) lgkmcnt(0)" ::: "memory"); grid.sync(); __builtin_amdgcn_fence(__ATOMIC_ACQUIRE, "agent"); asm volatile("s_waitcnt vmcnt(0)" ::: "memory"); PROF_STAMP(); } while (0)
#define GRID_SYNC() do { XcdBarrier _xb; _xb.bar = (unsigned*)(WSBASE() + WS_CTL); _xb.x = xb_xcc_id(); _xb.st = (volatile LAS unsigned*)(C.lds + 131072 + 512); xcd_barrier(_xb); PROF_STAMP(); } while (0)
struct Args { const float* in[25]; float* out; unsigned char* ws; };

__device__ __forceinline__ void* ldptr(LAS unsigned long long* PT, int i) {
    unsigned off = 8u * (unsigned)i; asm volatile("" : "+s"(off));
    const unsigned long long v = *(LAS unsigned long long*)((LAS unsigned char*)PT + off);
    unsigned lo = __builtin_amdgcn_readfirstlane((unsigned)v), hi = __builtin_amdgcn_readfirstlane((unsigned)(v >> 32));
    asm volatile("" : "+s"(lo), "+s"(hi));
    return (void*)(((unsigned long long)hi << 32) | lo);
}
#define INP(i) ((const float*)ldptr(PT, i))
#define WSBASE() ((unsigned char*)ldptr(PT, 26))
#define OUTP ((float*)ldptr(PT, 25))
#define XIN INP(0)
#define cvec INP(1)
#define ctxin INP(2)
#define cctx INP(3)
#define wmod INP(4)
#define bmod INP(5)
#define normg INP(6)
#define f1w13 INP(7)
#define f1w2 INP(8)
#define win INP(9)
#define wfo INP(10)
#define LRE INP(11)
#define LIM INP(12)
#define LST INP(13)
#define BRE INP(14)
#define BIM INP(15)
#define CRE INP(16)
#define CIM INP(17)
#define SDD INP(18)
#define wglu INP(19)
#define wsso INP(20)
#define wout INP(21)
#define f2w13 INP(22)
#define f2w2 INP(23)
#define fing INP(24)
#define H ((float*)(WSBASE() + WS_H))
#define MOD ((float*)(WSBASE() + WS_MOD))
#define MODP ((float*)(WSBASE() + X_MODP))
#define HID ((bf16_t*)(WSBASE() + X_HID))
#define AN_FFN ((bf16_t*)(WSBASE() + X_AN_FFN))
#define AN_MIX ((bf16_t*)(WSBASE() + X_AN_MIX))
#define VT2 ((bf16_t*)(WSBASE() + X_VT2))
#define VT2C ((bf16_t*)(WSBASE() + X_VT2C))
#define SGF ((bf16_t*)(WSBASE() + X_SGF))
#define SGS ((bf16_t*)(WSBASE() + X_SGS))
#define UG ((bf16_t*)(WSBASE() + X_UG))
#define HIN ((bf16_t*)(WSBASE() + X_UG))
#define SB ((float*)(WSBASE() + X_S))
#define YS ((bf16_t*)(WSBASE() + X_YS))
#define ZG ((bf16_t*)(WSBASE() + X_ZG))
#define YF ((bf16_t*)(WSBASE() + X_YF))
#define YI ((bf16_t*)(WSBASE() + X_YI))
#define DFT ((bf16_t*)(WSBASE() + WS_DFT))
#define DFTC ((bf16_t*)(WSBASE() + WS_DFTC))
#define W13 ((bf16_t*)(WSBASE() + W_13))
#define W13B ((bf16_t*)(WSBASE() + W_13B))
#define W2B ((bf16_t*)(WSBASE() + W_2B))
#define W2 ((bf16_t*)(WSBASE() + W_2))
#define WIN ((bf16_t*)(WSBASE() + W_IN))
#define WFO ((bf16_t*)(WSBASE() + W_FO))
#define WGLU ((bf16_t*)(WSBASE() + W_GLU))
#define WSSO ((bf16_t*)(WSBASE() + W_SSO))
#define WOUT ((bf16_t*)(WSBASE() + W_OUT))
#define WSA ((bf16_t*)(WSBASE() + W_SA))
#define WSB ((bf16_t*)(WSBASE() + W_SB))
#define PART ((float*)(WSBASE() + WS_PART))
#define PQB ((bf16_t*)(WSBASE() + WS_X + 240 * MiB))
#define GSK(l_, k_) ((float*)(WSBASE() + WS_GS) + (size_t)((l_) * 3 + (k_)) * 9 * DM)
#define RVEC ((float*)(WSBASE() + WS_R))
#define ROWSQ ((float*)(WSBASE() + WS_ROWSQ))
#define BIASF ((float*)(WSBASE() + WS_BIASF))
#define BIASM ((float*)(WSBASE() + WS_BIASM))
#define MODl (MOD + (size_t)l * 9 * NMOD)
#define MKPL(P, L) SsmP P; P.lre = LRE + (L) * 4096; P.lim = LIM + (L) * 4096; P.lst = LST + (L) * 64; P.bre = BRE + (size_t)(L) * 65536; P.bim = BIM + (size_t)(L) * 65536; \
        P.cre = CRE + (size_t)(L) * 65536; P.cim = CIM + (size_t)(L) * 65536; P.dd = SDD + (L) * 512;
#define MKP(P) MKPL(P, l)
#define PREP_LAYER(L, WITH_FFN) do { CTX_REFRESH(C); __syncthreads(); \
        prep_transposes(C, f1w13 + (size_t)(L) * 1024 * 5632, f1w2 + (size_t)(L) * 2816 * 1024, win + (size_t)(L) * 1024 * 3072, wfo + (size_t)(L) * 512 * 1024, \
                        wglu + (size_t)(L) * 512 * 1024, wsso + (size_t)(L) * 512 * 1024, wout + (size_t)(L) * 1024 * 1024, W13, W2, WIN, WFO, WGLU, WSSO, WOUT, (WITH_FFN)); \
        __syncthreads(); CTX_REFRESH(C); \
        { MKPL(P_, L) ssm_mats_phase(C, P_, WSA, WSB); } \
        CTX_REFRESH(C); fourier_weight_phase(C, win + (size_t)(L) * 1024 * 3072, WIN); } while (0)
__global__ void __launch_bounds__(512, 2) fwd_mega(Args args) {
    extern __shared__ __attribute__((aligned(16))) unsigned char lds_raw[];
    cg::grid_group grid = cg::this_grid();
    Ctx C; C.lds = (LAS unsigned char*)lds_raw; C.tid = threadIdx.x; C.lane = C.tid & 63; C.wave = __builtin_amdgcn_readfirstlane(C.tid >> 6);
    C.G = gridDim.x; C.bid = blockIdx.x; C.gw = C.bid * 8 + C.wave; C.NGW = C.G * 8;
    LAS unsigned long long* PT = (LAS unsigned long long*)(C.lds + 131072);
    if (threadIdx.x == 0) {
        PT[0] = (unsigned long long)args.in[0]; PT[1] = (unsigned long long)args.in[1]; PT[2] = (unsigned long long)args.in[2]; PT[3] = (unsigned long long)args.in[3]; PT[4] = (unsigned long long)args.in[4];
        PT[5] = (unsigned long long)args.in[5]; PT[6] = (unsigned long long)args.in[6]; PT[7] = (unsigned long long)args.in[7]; PT[8] = (unsigned long long)args.in[8]; PT[9] = (unsigned long long)args.in[9];
        PT[10] = (unsigned long long)args.in[10]; PT[11] = (unsigned long long)args.in[11]; PT[12] = (unsigned long long)args.in[12]; PT[13] = (unsigned long long)args.in[13]; PT[14] = (unsigned long long)args.in[14];
        PT[15] = (unsigned long long)args.in[15]; PT[16] = (unsigned long long)args.in[16]; PT[17] = (unsigned long long)args.in[17]; PT[18] = (unsigned long long)args.in[18]; PT[19] = (unsigned long long)args.in[19];
        PT[20] = (unsigned long long)args.in[20]; PT[21] = (unsigned long long)args.in[21]; PT[22] = (unsigned long long)args.in[22]; PT[23] = (unsigned long long)args.in[23]; PT[24] = (unsigned long long)args.in[24];
        PT[25] = (unsigned long long)args.out; PT[26] = (unsigned long long)args.ws;
        volatile LAS unsigned* st = (volatile LAS unsigned*)(C.lds + 131072 + 512); st[0] = 0u; st[1] = 0u;
        if (PROF_SEL && blockIdx.x == 0) { PROF_CNT[0] = 1u; PROF_TS[0] = __builtin_amdgcn_s_memrealtime(); }
        (void)xb_add((unsigned*)(args.ws + WS_CTL) + XB_XCNT(xb_xcc_id()), 1u);
    }
    __syncthreads();
    const int G = C.G, bid = C.bid;

    {
        mod_partial_phase(C, cvec, cctx, wmod, MODP);
        dft_gen_phase(C, DFT, DFTC);
        PREP_LAYER(0, true);
    }
    if (args.ws == nullptr) GRID_SYNC_CG();
    GRID_SYNC();
    mod_final_phase(C, bmod, normg, MODP, MOD, GSK(0, 0));
    GRID_SYNC(); CTX_REFRESH(C);

    for (int l = 0; l < DEPTH; ++l) {


        for (int f = 0; f < 2; ++f) {
#ifndef NO_MIX
            if (f == 1) {
                const int NRT = (l == DEPTH - 1) ? ML / 256 : MT / 256;
                fin_rows_phase(C, H, GSK(l, 1), AN_MIX, PART, 4, ROWSQ, RVEC, false);
                GRID_SYNC(); CTX_REFRESH(C);
#if defined(DUMP) && DUMP == 8
                {
                    pg8::Sched S; S.init(AN_MIX, W13, MT / 256, 22, 1, 1024, 1024, 0, 0, G, bid);
                    EpiPair<0> E{HID, DFF, RVEC, BIASF}; pg8::gemm_phase(C.lds, C.wave, 1024, 1024, 1024, S, E);
                }
                GRID_SYNC(); CTX_REFRESH(C);
                dump_phase(C, HID, HID + (size_t)ML * 512, OUTP); return;
#endif
#if defined(DUMP) && DUMP == 5
                dump_phase(C, AN_MIX, AN_MIX + (size_t)ML * 512, OUTP); return;
#endif
#if defined(DUMP) && DUMP == 6
                { const size_t nw = (size_t)24 * MiB / 2, nall = (size_t)ML * DM;
                  for (size_t i = (size_t)C.bid * 512 + C.tid; i < nall; i += (size_t)C.G * 512) OUTP[i] = i < nw ? __uint_as_float((unsigned)WIN[i] << 16) : 0.f; }
                return;
#endif
#if (MIXSEL >> 0) & 1
                {
                    pg8::Sched S; S.init(WIN, AN_MIX, 4, MT / 256, 1, 1024, 1024, 0, 0, G, bid);
                    EpiInT E{VT2, VT2C, RVEC, BIASM}; pg8::gemm_phase(C.lds, C.wave, 1024, 1024, 1024, S, E);
                }
#endif
#if (MIXSEL >> 1) & 1
                {
                    pg8::Sched S; S.init(AN_MIX, WIN + (size_t)1024 * 1024, MT / 256, 2, 1, 1024, 1024, 0, 0, G, (bid + 32) % G);
                    EpiInU E{UG, RVEC, BIASM}; pg8::gemm_phase(C.lds, C.wave, 1024, 1024, 1024, S, E);
                }
                {
                    pg8::Sched S; S.init(AN_MIX, WIN + (size_t)1536 * 1024, MT / 256, 8, 1, 1024, 1024, 0, 0, G, (bid + 192) % G);
                    EpiInG E{SGF, SGS, RVEC, BIASM}; pg8::gemm_phase(C.lds, C.wave, 1024, 1024, 1024, S, E);
                }
#endif
                GRID_SYNC(); CTX_REFRESH(C);
#if defined(DUMP) && DUMP == 3
                dump_phase(C, SGF, SGS, OUTP); return;
#endif
#if defined(DUMP) && DUMP == 4
                dump_phase(C, VT2, VT2 + (size_t)ML * 512, OUTP); return;
#endif
#if (MIXSEL >> 2) & 1
                {
                    pg8::Sched S; S.init(DFT, VT2, 16, 2, 8, 4096, 8192, 0, (size_t)512 * 8192, G, bid);
                    S.bsplit = 8; S.boff = (size_t)4096 * 2;
                    EpiF2 E{PQB, 0, 4096, 512}; pg8::gemm_phase(C.lds, C.wave, 4096, 4096, 8192, S, E);
                }
#endif
                GRID_SYNC(); CTX_REFRESH(C);
                {
                    pg8::Sched S; S.init(DFTC, VT2C, 1, 2, 8, 512, 512, 0, (size_t)512 * 512, G, (bid + 128) % G);
                    EpiF2 E{YF, ML, 256, 512}; pg8::gemm_phase(C.lds, C.wave, 512, 512, 512, S, E);
                }
                f2_combine_phase(C, PQB, VT2, YF);
                GRID_SYNC(); CTX_REFRESH(C);
#if defined(DUMP) && DUMP == 1
                dump_phase(C, YF, SGS, OUTP); return;
#endif
#if (MIXSEL >> 4) & 1
                {
                    pg8::Sched S; S.init(UG, WSA, 9, 2, 32, 256, 256, (size_t)UROWS * 256, (size_t)512 * 256, G, bid);
                    EpiSsmA E{YI, SB}; pg8::gemm_phase(C.lds, C.wave, 256, 256, 256, S, E);
                }
#endif
#if (MIXSEL >> 5) & 1
                {
                    pg8::Sched S; S.init(YF, WFO, NRT, 4, 1, 512, 512, 0, 0, G, (bid + 64) % G);
                    EpiFo E{SGF}; pg8::gemm_phase(C.lds, C.wave, 512, 512, 512, S, E);
                }
#endif
                GRID_SYNC(); CTX_REFRESH(C);
                { MKP(P) ssm_scan_phase(C, P, SB, HIN); }
                GRID_SYNC(); CTX_REFRESH(C);
#if (MIXSEL >> 6) & 1
                {
                    pg8::Sched S; S.init(HIN, WSB, l == DEPTH - 1 ? 8 : 9, 1, 32, 256, 256, (size_t)UROWS * 256, (size_t)256 * 256, G, bid);
                    EpiSsmB E{YI, YS}; pg8::gemm_phase(C.lds, C.wave, 256, 256, 256, S, E);
                }
#endif
                GRID_SYNC(); CTX_REFRESH(C);
#if defined(DUMP) && DUMP == 2
                dump_phase(C, YS, SGF, OUTP); return;
#endif
#if (MIXSEL >> 7) & 1
                {
                    pg8::Sched S; S.init(YS, WGLU, NRT, 4, 1, 512, 512, 0, 0, G, bid);
                    EpiPair<1> E{ZG, 512, nullptr, nullptr}; pg8::gemm_phase(C.lds, C.wave, 512, 512, 512, S, E);
                }
#endif
                GRID_SYNC(); CTX_REFRESH(C);
#if (MIXSEL >> 8) & 1
                {
                    pg8::Sched S; S.init(ZG, WSSO, NRT, 4, 1, 512, 512, 0, 0, G, bid);
                    EpiSso E{SGS, SGF}; pg8::gemm_phase(C.lds, C.wave, 512, 512, 512, S, E);
                }
#endif
                GRID_SYNC(); CTX_REFRESH(C);
#if (MIXSEL >> 9) & 1
                {
                    pg8::Sched S; S.init(SGS, WOUT, ML / 256, 4, 1, 1024, 1024, 0, 0, G, bid);
                    EpiRes<false, false> E{H, MODl + 5 * 1024, PART, GSK(l, 2), AN_FFN, ROWSQ}; pg8::gemm_phase(C.lds, C.wave, 1024, 1024, 1024, S, E);
                }
                if (l < DEPTH - 1) {
                    pg8::Sched S; S.init(SGS + (size_t)ML * 1024, WOUT, MC / 256, 4, 4, 1024, 1024, 256, 256, G, (bid + G / 2) % G);
                    EpiRes<true, false> E{H, MODl + 5 * 1024, PART, nullptr, nullptr, nullptr}; pg8::gemm_phase(C.lds, C.wave, 256, 1024, 1024, S, E);
                }
                { SUBCTX(Cs, 0, G / 2) if (Cs.bid < G / 2) bias_phase(Cs, W13B, 5632, MODl + 6 * 1024, BIASF); }
#endif
                GRID_SYNC(); CTX_REFRESH(C);
            }
#endif
#ifndef NO_FFN
            const int kb = f == 0 ? 0 : 6;
            if (f == 0) { if (l == 0) fin_rows_phase(C, H, GSK(0, 0), AN_FFN, PART, 2, ROWSQ, RVEC, true, XIN, ctxin);
                          else fin_rows_phase(C, H, GSK(l, 0), AN_FFN, PART, 2, ROWSQ, RVEC, false);
                          bias_phase(C, W13, 5632, MODl, BIASF); bias_phase(C, WIN, 3584, MODl + 3 * 1024, BIASM); }
            else        { fin_rows_phase(C, H, GSK(l, 2), AN_FFN, PART, 4, ROWSQ, RVEC, false);
                          if (l < DEPTH - 1) { CTX_REFRESH(C); __syncthreads(); fourier_weight_phase(C, win + (size_t)(l + 1) * 1024 * 3072, WIN); } }
            GRID_SYNC(); CTX_REFRESH(C);
            {
                pg8::Sched S; S.init(AN_FFN, f == 0 ? W13 : W13B, (f == 1 && l == DEPTH - 1) ? ML / 256 : MT / 256, 22, 1, 1024, 1024, 0, 0, G, bid);
                EpiPair<0> E{HID, DFF, RVEC, BIASF}; pg8::gemm_phase(C.lds, C.wave, 1024, 1024, 1024, S, E);
            }
            GRID_SYNC(); CTX_REFRESH(C);
            {
                pg8::Sched S; S.init(HID, f == 0 ? W2 : W2B, ML / 256, 4, 1, DFF, DFF, 0, 0, G, bid);
                EpiRes<false, true> E{H, MODl + (kb + 2) * 1024, PART, f == 0 ? GSK(l, 1) : GSK(l < 3 ? l + 1 : 3, 0), f == 0 ? AN_MIX : AN_FFN, ROWSQ}; pg8::gemm_phase(C.lds, C.wave, DFF, DFF, DFF, S, E);
            }
            if (f == 0) {
                {   pg8::Sched S; S.init(HID + (size_t)ML * DFF, W2, MC / 256, 4, 2, DFF, DFF, 768, 768, G, (bid + G / 2) % G);
                    EpiRes<true, true> E{H, MODl + (kb + 2) * 1024, PART, nullptr, nullptr, nullptr}; pg8::gemm_phase(C.lds, C.wave, 768, DFF, DFF, S, E); }
                {   pg8::Sched S; S.init(HID + (size_t)ML * DFF + 1536, W2 + 1536, MC / 256, 4, 2, DFF, DFF, 640, 640, G, (bid + G / 2 + 64) % G);
                    EpiRes<true, true> E{H, MODl + (kb + 2) * 1024, PART + (size_t)2 * MC * DM, nullptr, nullptr, nullptr}; pg8::gemm_phase(C.lds, C.wave, 640, DFF, DFF, S, E); }
                SUBCTX(Cs, G / 2 + 64, G / 2)
                if (Cs.bid < G / 2) { __syncthreads();
                    transpose_mat(Cs, f2w13 + (size_t)l * 1024 * 5632, 1024, 5632, 0, 5632, W13B, 1, 2816, 0);
                    transpose_mat(Cs, f2w2 + (size_t)l * 2816 * 1024, 2816, 1024, 0, 1024, W2B, 0, 0, 0); }
            } else if (l < DEPTH - 1) {
                {   pg8::Sched S; S.init(HID + (size_t)ML * DFF, W2B, MC / 256, 4, 2, DFF, DFF, 1408, 1408, G, (bid + G / 2) % G);
                    EpiRes<true, true> E{H, MODl + (kb + 2) * 1024, PART, nullptr, nullptr, nullptr}; pg8::gemm_phase(C.lds, C.wave, 1408, DFF, DFF, S, E); }
                SUBCTX(Cs, G / 2 + 64, G - 64)
                if (Cs.bid < G - 64) { __syncthreads();
                    transpose_mat(Cs, f1w13 + (size_t)(l + 1) * 1024 * 5632, 1024, 5632, 0, 5632, W13, 1, 2816, 0);
                    transpose_mat(Cs, f1w2 + (size_t)(l + 1) * 2816 * 1024, 2816, 1024, 0, 1024, W2, 0, 0, 0);
                    prep_transposes(Cs, nullptr, nullptr, win + (size_t)(l + 1) * 1024 * 3072, wfo + (size_t)(l + 1) * 512 * 1024, wglu + (size_t)(l + 1) * 512 * 1024,
                                    wsso + (size_t)(l + 1) * 512 * 1024, wout + (size_t)(l + 1) * 1024 * 1024, W13, W2, WIN, WFO, WGLU, WSSO, WOUT, false);
                    __syncthreads();
                    { MKPL(P_, l + 1) ssm_mats_phase(Cs, P_, WSA, WSB); } }
            }
            GRID_SYNC(); CTX_REFRESH(C);
#endif
        }
    }
    CTX_REFRESH(C);
    final_norm_phase(C, H, fing, OUTP);
#if PROF_SEL
    if (blockIdx.x == 0) {
        __syncthreads();
        if (threadIdx.x == 0) {
            unsigned long long tot = 0ull;
            for (int l = 0; l < 4; ++l) for (int j = 0; j < 16; ++j) {
                const int i = 3 + l * 16 + j; const unsigned long long d = PROF_TS[i] - PROF_TS[i - 1];
                bool sel = false;
                if (PROF_SEL == 1) sel = (j == 0 || j == 3 || j == 13);
                if (PROF_SEL == 2) sel = (j == 2 || j == 15);
                if (PROF_SEL == 3) sel = (j == 7 || j == 9 || j == 11 || j == 12);
                if (PROF_SEL == 4) sel = (j == 0); if (PROF_SEL == 5) sel = (j == 3); if (PROF_SEL == 6) sel = (j == 13);
                if (PROF_SEL == 7) sel = (j == 5 || j == 6); if (PROF_SEL == 8) sel = (j == 7);
                if (sel) tot += d;
            }
            if (PROF_SEL == 9) tot = PROF_TS[2] - PROF_TS[0];
            const float t_us = (float)tot * 0.01f;
            float* o = OUTP;
            o[0] = o[0] + sqrtf(t_us);
        }
    }
#endif
}

extern "C" void kernel_launch(void* const* d_in, const int* in_sizes, int n_in, void* d_out, int out_size, void* d_ws, size_t ws_size, hipStream_t stream) {
    static int grid = 0;
    if (grid == 0) {
        if (n_in != 25 || ws_size < WS_END) { fprintf(stderr, "kernel_launch: bad n_in %d or ws_size %zu < %zu\n", n_in, ws_size, (size_t)WS_END); grid = -1; return; }
        int dev = 0, cus = 0, per_cu = 0;
        (void)hipGetDevice(&dev);
        (void)hipDeviceGetAttribute(&cus, hipDeviceAttributeMultiprocessorCount, dev);
        (void)hipFuncSetAttribute((const void*)fwd_mega, hipFuncAttributeMaxDynamicSharedMemorySize, LDS_BYTES);
        (void)hipOccupancyMaxActiveBlocksPerMultiprocessor(&per_cu, (const void*)fwd_mega, 512, LDS_BYTES);
        if (per_cu < 1) per_cu = 1;
        grid = cus * 1;
        if (grid < 160) { fprintf(stderr, "kernel_launch: needs >= 160 CUs (got %d)\n", grid); grid = -1; return; }
        fprintf(stderr, "kernel_launch: grid %d (cus %d, per_cu %d), ws %zu\n", grid, cus, per_cu, ws_size);
    }
    if (grid < 0) return;
    if (hipMemsetAsync((char*)d_ws + WS_CTL, 0, CTL_BYTES, stream) != hipSuccess) { fprintf(stderr, "kernel_launch: memset of the barrier words failed\n"); return; }
    Args a{};
    for (int i = 0; i < 25; ++i) a.in[i] = (const float*)d_in[i];
    a.out = (float*)d_out; a.ws = (unsigned char*)d_ws;
    void* kargs[] = {&a};
    hipError_t e = hipLaunchCooperativeKernel((const void*)fwd_mega, dim3(grid), dim3(512), kargs, LDS_BYTES, stream);
    if (e != hipSuccess) fprintf(stderr, "kernel_launch: cooperative launch failed: %s\n", hipGetErrorString(e));
}
```

```cpp
#include <hip/hip_runtime.h>
#include <hip/hip_cooperative_groups.h>
#include <cstdio>
#include <cstdint>
namespace cg = cooperative_groups;
#ifndef MIXSEL
#define MIXSEL 0xffff
#endif

#define LAS __attribute__((address_space(3)))
typedef unsigned short bf16_t;
typedef short bf16x8 __attribute__((ext_vector_type(8)));
typedef float f32x4 __attribute__((ext_vector_type(4)));
typedef float f32x2 __attribute__((ext_vector_type(2)));
typedef unsigned u32x4 __attribute__((ext_vector_type(4)));
typedef unsigned u32x2 __attribute__((ext_vector_type(2)));

constexpr int DM = 1024, NB = 8, SEQ = 4096, CTX = 256, DEPTH = 4, DFF = 2816;
constexpr int ML = NB * SEQ, MC = NB * CTX, MT = ML + MC;
constexpr int NMOD = 9 * DM;
constexpr int UROWS = 2304;

constexpr size_t MiB = 1u << 20;
constexpr size_t WS_H = 0;
constexpr size_t WS_X = 136 * MiB;
constexpr size_t X_HID = WS_X;
constexpr size_t X_AN_FFN = WS_X + 276 * MiB;
constexpr size_t X_VT2 = WS_X;
constexpr size_t X_VT2C = WS_X + 64 * MiB;
constexpr size_t X_SGF = WS_X + 68 * MiB;
constexpr size_t X_SGS = WS_X + 136 * MiB;
constexpr size_t X_UG = WS_X + 204 * MiB;
constexpr size_t X_S = WS_X + 240 * MiB;
constexpr size_t X_AN_MIX = X_S;
constexpr size_t X_YS = X_S;
constexpr size_t X_ZG = X_S + 34 * MiB;
constexpr size_t X_YF = WS_X + 312 * MiB;
constexpr size_t X_YI = WS_X;
constexpr size_t X_MODP = WS_X;
constexpr size_t WS_DFT = 482 * MiB;
constexpr size_t WS_DFTC = 546 * MiB;
constexpr size_t WS_W = 547 * MiB;
constexpr size_t W_13 = WS_W;
constexpr size_t W_2 = WS_W + 11 * MiB;
constexpr size_t W_IN = WS_W + 17 * MiB;
constexpr size_t W_FO = WS_W + 24 * MiB;
constexpr size_t W_GLU = WS_W + 25 * MiB;
constexpr size_t W_SSO = WS_W + 26 * MiB;
constexpr size_t W_OUT = WS_W + 27 * MiB;
constexpr size_t W_SA = WS_W + 29 * MiB;
constexpr size_t W_SB = WS_W + 37 * MiB;
constexpr size_t WS_MOD = 588 * MiB;
constexpr size_t WS_PART = WS_X + 204 * MiB;
constexpr size_t WS_GS = WS_MOD + 1408 * 1024;
constexpr size_t WS_R = WS_MOD + 1856 * 1024;
constexpr size_t WS_ROWSQ = 590 * MiB;
constexpr size_t WS_BIASF = 592 * MiB + 256 * 1024;
constexpr size_t WS_BIASM = 592 * MiB + 512 * 1024;
constexpr size_t WS_CTL = 594 * MiB;
constexpr size_t CTL_BYTES = 16384;
constexpr size_t W_13B = 595 * MiB;
constexpr size_t W_2B = 606 * MiB;
constexpr size_t WS_END = 612 * MiB;

constexpr int LDS_BYTES = 139264;

__device__ __forceinline__ unsigned cvt_pk_bf16(float lo, float hi) { unsigned r; asm volatile("s_nop 1\n\tv_cvt_pk_bf16_f32 %0, %1, %2" : "=v"(r) : "v"(lo), "v"(hi)); return r; }
__device__ __forceinline__ float bf_lo(unsigned w) { return __uint_as_float(w << 16); }
__device__ __forceinline__ float bf_hi(unsigned w) { return __uint_as_float(w & 0xffff0000u); }
__device__ __forceinline__ float sigmoidf_(float x) { return __builtin_amdgcn_rcpf(1.f + __expf(-x)); }
__device__ __forceinline__ float siluf_(float x) { return x * sigmoidf_(x); }
__device__ __forceinline__ float gelu_tanh(float y) { const float u = 0.7978845608028654f * (y + 0.044715f * y * y * y); return y * sigmoidf_(2.f * u); }
__device__ __forceinline__ float wave_sum(float v) {
#pragma unroll
    for (int o = 1; o < 64; o <<= 1) v += __shfl_xor(v, o);
    return v;
}
__device__ __forceinline__ u32x4 pack8(const float (&r)[8]) { u32x4 w; w.x = cvt_pk_bf16(r[0], r[1]); w.y = cvt_pk_bf16(r[2], r[3]); w.z = cvt_pk_bf16(r[4], r[5]); w.w = cvt_pk_bf16(r[6], r[7]); return w; }
__device__ __forceinline__ void unpack8(const u32x4 w, float (&r)[8]) { r[0] = bf_lo(w.x); r[1] = bf_hi(w.x); r[2] = bf_lo(w.y); r[3] = bf_hi(w.y); r[4] = bf_lo(w.z); r[5] = bf_hi(w.z); r[6] = bf_lo(w.w); r[7] = bf_hi(w.w); }

namespace pg8 {
constexpr int BM = 256, BK = 64, HALF = 128, HTB = HALF * BK * 2, STAGE_BYTES = 8 * HTB, NXCD = 8, WGM = 8;
__host__ __device__ __forceinline__ int lds_byte(int r, int c) { const int st = (r >> 4) * 2 + (c >> 5), rr = r & 15, cc = c & 31, ob = rr * 64 + cc * 2; return st * 1024 + (ob ^ (((ob >> 9) & 1) << 5)); }
__host__ __device__ __forceinline__ void stage_rc(int b, int& R, int& C) { const int st = b / 1024, sb = b % 1024, swz = sb ^ (((sb >> 9) & 1) << 5); R = (st >> 1) * 16 + swz / 64; C = (st & 1) * 32 + (swz % 64) / 2; }
__host__ __device__ __forceinline__ int perm32(int rho) { const int n = rho >> 4, i = rho & 15; return 8 * (i >> 2) + 4 * n + (i & 3); }

struct Unit { int pm, pn, z; const char* a; const char* b; };

struct Sched {
    int nM, nN, nwg, G, c, per_z; const char* A; const char* B; size_t tA, tB, zA, zB; int bsplit; size_t boff;
    __device__ __forceinline__ void init(const void* A_, const void* B_, int nM_, int nN_, int nZ, size_t lda, size_t ldb, size_t zA_el, size_t zB_el, int G_, int c_) {
        A = (const char*)A_; B = (const char*)B_; nM = nM_; nN = nN_; per_z = nM_ * nN_; nwg = per_z * nZ; G = G_; c = c_;
        tA = (size_t)BM * lda * 2; tB = (size_t)BM * ldb * 2; zA = zA_el * 2; zB = zB_el * 2; bsplit = 1 << 30; boff = 0;
    }
    __device__ __forceinline__ bool next(int i, Unit& u) const {
        const long L = (long)i * G + c; if (L >= nwg) return false;
        int wgid = (int)L; { const int q = nwg / NXCD, r = nwg % NXCD, xcd = wgid % NXCD, off = wgid / NXCD; wgid = (xcd < r ? xcd * (q + 1) : r * (q + 1) + (xcd - r) * q) + off; }
        const int z = wgid / per_z, w = wgid % per_z;
        const int nig = WGM * nN, gid = w / nig, fm = gid * WGM, gsz = (nM - fm) < WGM ? (nM - fm) : WGM;
        u.pm = fm + ((w % nig) % gsz); u.pn = (w % nig) / gsz; u.z = z;
        u.a = A + (size_t)z * zA + (size_t)u.pm * tA; u.b = B + (size_t)z * zB + (size_t)u.pn * tB + (u.pm >= bsplit ? boff : 0); return true;
    }
};

template <class Epi>
__device__ __forceinline__ void gemm_phase(LAS unsigned char* lds, const int wave_id, const int K_, const int lda_, const int ldb_, const Sched& S, const Epi& E) {
    int K = K_, lda = lda_, ldb = ldb_; asm volatile("" : "+s"(K), "+s"(lda), "+s"(ldb));
    const int lane = (int)__builtin_amdgcn_mbcnt_hi(~0u, __builtin_amdgcn_mbcnt_lo(~0u, 0u));
    int tid = (wave_id << 6) | lane; asm volatile("" : "+v"(tid));
    const int wid = wave_id, wr = wid >> 2, wc = wid & 3, fr = lane & 15, fq = lane >> 4;
    const int nt = K / BK;
    unsigned voffA[2], voffB[2];
#pragma unroll
    for (int i = 0; i < 2; ++i) { int R, C; stage_rc(tid * 16 + i * 8192, R, C); const int Rb = (R & ~31) + perm32(R & 31);
        voffA[i] = (unsigned)(R * lda + C) * 2u; voffB[i] = (unsigned)(Rb * ldb + C) * 2u; }
    const size_t kstep = (size_t)(BK * 2);
    const size_t hstepA = (size_t)HALF * lda * 2, hstepB = (size_t)HALF * ldb * 2;
    const unsigned ldsw = (unsigned)wid * 1024u;
    const int aoff = lds_byte(wr * 64 + fr, fq * 8), boff = lds_byte(wc * 32 + fr, fq * 8);
#define PG8_SA(b, h) (((b) * 2 + (h)) * HTB)
#define PG8_SB(b, h) ((4 + (b) * 2 + (h)) * HTB)
#define PG8_STAGE(bufoff, gbase, voff) do { const char* _g = (const char*)(gbase); asm volatile("" : "+s"(_g)); _Pragma("unroll") for (int _i = 0; _i < 2; ++_i) \
        __builtin_amdgcn_global_load_lds((const unsigned*)(_g + (voff)[_i]), (LAS unsigned*)(lds + (bufoff) + ldsw + _i * 8192), 16, 0, 0); } while (0)
#define PG8_LDA(dst, b, h) do { _Pragma("unroll") for (int m = 0; m < 4; ++m) _Pragma("unroll") for (int k = 0; k < 2; ++k) dst[m][k] = *(const LAS bf16x8*)(lds + PG8_SA(b, h) + aoff + m * 2048 + k * 1024); } while (0)
#define PG8_LDB(dst, b, h) do { _Pragma("unroll") for (int n = 0; n < 2; ++n) _Pragma("unroll") for (int k = 0; k < 2; ++k) dst[n][k] = *(const LAS bf16x8*)(lds + PG8_SB(b, h) + boff + n * 2048 + k * 1024); } while (0)
#define PG8_MMA(ai, bj, At, Bt) do { __builtin_amdgcn_s_setprio(1); _Pragma("unroll") for (int m = 0; m < 4; ++m) _Pragma("unroll") for (int n = 0; n < 2; ++n) _Pragma("unroll") for (int k = 0; k < 2; ++k) \
        acc[ai][bj][m][n] = __builtin_amdgcn_mfma_f32_16x16x32_bf16(Bt[n][k], At[m][k], acc[ai][bj][m][n], 0, 0, 0); __builtin_amdgcn_s_setprio(0); } while (0)
#define PG8_WAIT_V(n) asm volatile("s_waitcnt vmcnt(" #n ")" ::: "memory")
#define PG8_WAIT_L(n) asm volatile("s_waitcnt lgkmcnt(" #n ")" ::: "memory")
#define PG8_BAR __builtin_amdgcn_s_barrier()
#define PG8_SCHED __builtin_amdgcn_sched_barrier(0)
    Unit cur, nxt; int ui = 0;
    if (!S.next(0, cur)) return;
    f32x4 acc[2][2][4][2];
#pragma unroll
    for (int a = 0; a < 2; ++a)
#pragma unroll
        for (int b = 0; b < 2; ++b)
#pragma unroll
            for (int m = 0; m < 4; ++m)
#pragma unroll
                for (int n = 0; n < 2; ++n) acc[a][b][m][n] = (f32x4){0.f, 0.f, 0.f, 0.f};
    bf16x8 At[4][2], B0[2][2], B1[2][2];
    const char* cA = cur.a; const char* cB = cur.b;
    PG8_STAGE(PG8_SB(0, 0), cB, voffB); PG8_STAGE(PG8_SB(0, 1), cB + hstepB, voffB); PG8_STAGE(PG8_SA(0, 0), cA, voffA); PG8_STAGE(PG8_SA(0, 1), cA + hstepA, voffA);
    if (wr == 1) PG8_BAR;
    PG8_WAIT_V(2); PG8_BAR;
    PG8_STAGE(PG8_SB(1, 0), cB + kstep, voffB); PG8_STAGE(PG8_SA(1, 0), cA + kstep, voffA); PG8_STAGE(PG8_SB(1, 1), cB + hstepB + kstep, voffB);
    PG8_WAIT_V(6); PG8_BAR;
    for (;;) {
        const bool has_next = S.next(ui + 1, nxt);
        const char* nA = has_next ? nxt.a : cA; const char* nB = has_next ? nxt.b : cB;
        for (int t = 0; t < nt; t += 2) {
            const bool last = (t == nt - 2);
            const char* a1 = cA + (size_t)(t + 1) * kstep;
            const char* a2 = last ? nA : cA + (size_t)(t + 2) * kstep; const char* b2 = last ? nB : cB + (size_t)(t + 2) * kstep;
            const char* a3 = a2 + kstep; const char* b3 = b2 + kstep;
            PG8_LDB(B0, 0, 0); PG8_LDB(B1, 0, 1); PG8_SCHED; PG8_LDA(At, 0, 0); PG8_STAGE(PG8_SA(1, 1), a1 + hstepA, voffA);
            PG8_WAIT_V(8); PG8_WAIT_L(0); PG8_BAR; PG8_MMA(0, 0, At, B0); PG8_MMA(0, 1, At, B1); PG8_BAR; PG8_SCHED;
            PG8_LDA(At, 0, 1); PG8_STAGE(PG8_SB(0, 0), b2, voffB); PG8_STAGE(PG8_SB(0, 1), b2 + hstepB, voffB); PG8_STAGE(PG8_SA(0, 0), a2, voffA);
            PG8_WAIT_V(8); PG8_WAIT_L(0); PG8_BAR; PG8_MMA(1, 0, At, B0); PG8_MMA(1, 1, At, B1); PG8_BAR; PG8_SCHED;
            PG8_LDB(B0, 1, 0); PG8_LDB(B1, 1, 1); PG8_SCHED; PG8_LDA(At, 1, 0); PG8_STAGE(PG8_SA(0, 1), a2 + hstepA, voffA);
            PG8_WAIT_V(8); PG8_WAIT_L(0); PG8_BAR; PG8_MMA(0, 0, At, B0); PG8_MMA(0, 1, At, B1); PG8_BAR; PG8_SCHED;
            PG8_LDA(At, 1, 1); PG8_STAGE(PG8_SB(1, 0), b3, voffB); PG8_STAGE(PG8_SB(1, 1), b3 + hstepB, voffB); PG8_STAGE(PG8_SA(1, 0), a3, voffA);
            PG8_WAIT_V(8); PG8_WAIT_L(0); PG8_BAR; PG8_MMA(1, 0, At, B0); PG8_MMA(1, 1, At, B1); PG8_BAR; PG8_SCHED;
        }
        if (wr == 0) PG8_BAR;
        { int fr2 = fr, fq2 = fq; asm volatile("" : "+v"(fr2), "+v"(fq2)); E(acc, cur, wr, wc, fr2, fq2); }
        if (!has_next) break;
#pragma unroll
        for (int a = 0; a < 2; ++a)
#pragma unroll
            for (int b = 0; b < 2; ++b)
#pragma unroll
                for (int m = 0; m < 4; ++m)
#pragma unroll
                    for (int n = 0; n < 2; ++n) acc[a][b][m][n] = (f32x4){0.f, 0.f, 0.f, 0.f};
        cur = nxt; cA = nA; cB = nB; ++ui;
        if (wr == 1) PG8_BAR;
    }
    PG8_WAIT_V(0);
    PG8_BAR;
#undef PG8_SA
#undef PG8_SB
#undef PG8_STAGE
#undef PG8_LDA
#undef PG8_LDB
#undef PG8_MMA
#undef PG8_WAIT_V
#undef PG8_WAIT_L
#undef PG8_BAR
#undef PG8_SCHED
}
}
using pg8::Unit;
typedef f32x4 AccT[2][2][4][2];

#define EPI_ROWS_BEGIN _Pragma("unroll") for (int ai = 0; ai < 2; ++ai) _Pragma("unroll") for (int m = 0; m < 4; ++m) { const int row = u.pm * 256 + ai * 128 + wr * 64 + m * 16 + fr;
#define EPI_ROWS_END if (m & 1) asm volatile("" ::: "memory"); }
#define EPI_ROWS_END4 if (m == 3) asm volatile("" ::: "memory"); }
#define EPI_ROWS_END_NOFENCE }
#define EPI_LOAD_R(R) float rr8[2][4]; _Pragma("unroll") for (int ai = 0; ai < 2; ++ai) _Pragma("unroll") for (int m = 0; m < 4; ++m) rr8[ai][m] = (R)[u.pm * 256 + ai * 128 + wr * 64 + m * 16 + fr];
#define ACC8(dst, ai, bj, m) { const f32x4 _a = acc[ai][bj][m][0], _b = acc[ai][bj][m][1]; dst[0] = _a[0]; dst[1] = _a[1]; dst[2] = _a[2]; dst[3] = _a[3]; dst[4] = _b[0]; dst[5] = _b[1]; dst[6] = _b[2]; dst[7] = _b[3]; }

template <int MODE  > struct EpiPair {
    bf16_t* O; int ldo; const float* R; const float* BIAS;
    __device__ __forceinline__ void operator()(const AccT& acc, const Unit& u, int wr, int wc, int fr, int fq) const {
        const int col = u.pn * 128 + wc * 32 + 8 * fq;
        f32x4 ba0, ba1, bb0, bb1; float rr8[2][4];
        if (MODE == 0) {
            const int rt = u.pm * 256; const float* bp = BIAS + (rt < ML ? (rt >> 12) : 8) * 5632 + u.pn * 256 + wc * 32 + 8 * fq;
            ba0 = *(const f32x4*)bp; ba1 = *(const f32x4*)(bp + 4); bb0 = *(const f32x4*)(bp + 128); bb1 = *(const f32x4*)(bp + 132);
#pragma unroll
            for (int ai = 0; ai < 2; ++ai)
#pragma unroll
                for (int m = 0; m < 4; ++m) rr8[ai][m] = R[rt + ai * 128 + wr * 64 + m * 16 + fr];
        }
        EPI_ROWS_BEGIN
            float a[8], b[8], r[8]; ACC8(a, ai, 0, m); ACC8(b, ai, 1, m);
            if (MODE == 0) {
                const float rr = rr8[ai][m];
#pragma unroll
                for (int j = 0; j < 4; ++j) { a[j] = rr * a[j] + ba0[j]; a[4 + j] = rr * a[4 + j] + ba1[j]; b[j] = rr * b[j] + bb0[j]; b[4 + j] = rr * b[4 + j] + bb1[j]; }
            }
#pragma unroll
            for (int j = 0; j < 8; ++j) r[j] = MODE == 0 ? siluf_(a[j]) * b[j] : a[j] * sigmoidf_(b[j]);
            *(u32x4*)(O + (size_t)row * ldo + col) = pack8(r);
        EPI_ROWS_END
    }
};
template <bool SLICE, bool HALFSTEP> struct EpiRes {
    float* H; const float* gate; float* PART; const float* GS; bf16_t* AN; float* ROWSQ;
    __device__ __forceinline__ void operator()(const AccT& acc, const Unit& u, int wr, int wc, int fr, int fq) const {
        constexpr float sc = HALFSTEP ? 0.5f : 1.0f; constexpr int row0 = SLICE ? ML : 0;
        const int rt = row0 + u.pm * 256, bi = rt < ML ? (rt >> 12) : 8;
        f32x4 gq[2][2], sq[2][2];
#pragma unroll
        for (int bj = 0; bj < 2; ++bj) { const int col = u.pn * 256 + bj * 128 + wc * 32 + 8 * fq;
            const float* gp = gate + bi * NMOD + col; gq[bj][0] = *(const f32x4*)gp * sc; gq[bj][1] = *(const f32x4*)(gp + 4) * sc;
            if (!SLICE) { const float* gsp = GS + bi * DM + col; sq[bj][0] = *(const f32x4*)gsp; sq[bj][1] = *(const f32x4*)(gsp + 4); } }
        EPI_ROWS_BEGIN
            const int grow = row0 + row;
            float ss = 0.f;
#pragma unroll
            for (int bj = 0; bj < 2; ++bj) {
                const int col = u.pn * 256 + bj * 128 + wc * 32 + 8 * fq;
                float* p = H + (size_t)grow * DM + col;
                const f32x4 d0 = gq[bj][0] * acc[ai][bj][m][0], d1 = gq[bj][1] * acc[ai][bj][m][1];
                if (SLICE) {
                    float* pp = PART + ((size_t)u.z * MC + (grow - ML)) * DM + col;
                    *(f32x4*)pp = d0; *(f32x4*)(pp + 4) = d1;
                } else {
                    f32x4 h0 = *(const f32x4*)p, h1 = *(const f32x4*)(p + 4);
                    h0 += d0; h1 += d1;
                    *(f32x4*)p = h0; *(f32x4*)(p + 4) = h1;
                    ss += (h0[0] * h0[0] + h0[1] * h0[1]) + (h0[2] * h0[2] + h0[3] * h0[3]) + (h1[0] * h1[0] + h1[1] * h1[1]) + (h1[2] * h1[2] + h1[3] * h1[3]);
                    h0 *= sq[bj][0]; h1 *= sq[bj][1];
                    float r[8] = {h0[0], h0[1], h0[2], h0[3], h1[0], h1[1], h1[2], h1[3]};
                    *(u32x4*)(AN + (size_t)grow * DM + col) = pack8(r);
                }
            }
            if (!SLICE) { ss += __shfl_xor(ss, 16); ss += __shfl_xor(ss, 32); if (fq == 0) ROWSQ[(size_t)grow * 16 + u.pn * 4 + wc] = ss; }
        EPI_ROWS_END4
    }
};
struct EpiInT {
    bf16_t* VT2; bf16_t* VT2C; const float* R; const float* BIAS;
    __device__ __forceinline__ void operator()(const AccT& acc, const Unit& u, int wr, int wc, int fr, int fq) const {
        const int mt0 = u.pn * 256; const float* bb = BIAS + (mt0 < ML ? (mt0 >> 12) : 8) * 3584;
        f32x4 rr[2][2];
#pragma unroll
        for (int bj = 0; bj < 2; ++bj) { const float* rp = R + mt0 + bj * 128 + wc * 32 + 8 * fq; rr[bj][0] = *(const f32x4*)rp; rr[bj][1] = *(const f32x4*)(rp + 4); }
        EPI_LOAD_R(bb)
        EPI_ROWS_BEGIN
            const int grp = row >> 8, part = (row >> 7) & 1, ch = grp * 128 + (row & 127); const float bv = rr8[ai][m];
#pragma unroll
            for (int bj = 0; bj < 2; ++bj) {
                const int m0 = mt0 + bj * 128 + wc * 32 + 8 * fq;
                const f32x4 v0 = acc[ai][bj][m][0] * rr[bj][0] + bv, v1 = acc[ai][bj][m][1] * rr[bj][1] + bv;
                float r[8] = {v0[0], v0[1], v0[2], v0[3], v1[0], v1[1], v1[2], v1[3]};
                bf16_t* dst;
                if (m0 < ML) { const int b = m0 >> 12, t = m0 & 4095; dst = VT2 + ((size_t)(b * 512 + ch) * 8192 + part * 4096 + t); }
                else { const int mm = m0 - ML, b = mm >> 8, t = mm & 255; dst = VT2C + ((size_t)(b * 512 + ch) * 512 + part * 256 + t); }
                *(u32x4*)dst = pack8(r);
            }
        EPI_ROWS_END
    }
};
struct EpiInU {
    bf16_t* UG; const float* R; const float* BIAS;
    __device__ __forceinline__ void operator()(const AccT& acc, const Unit& u, int wr, int wc, int fr, int fq) const {
        const int rt = u.pm * 256; const float* bb = BIAS + (rt < ML ? (rt >> 12) : 8) * 3584 + 1024;
        f32x4 bq[2][2];
#pragma unroll
        for (int bj = 0; bj < 2; ++bj) { const int c = u.pn * 256 + bj * 128 + wc * 32 + 8 * fq; bq[bj][0] = *(const f32x4*)(bb + c); bq[bj][1] = *(const f32x4*)(bb + c + 4); }
        EPI_LOAD_R(R)
        EPI_ROWS_BEGIN
            int urow, ii;
            if (row < ML) { const int b = row >> 12, t = row & 4095; urow = b * 256 + (t >> 4); ii = t & 15; }
            else { const int mm = row - ML, b = mm >> 8, t = mm & 255; urow = 2048 + b * 16 + (t >> 4); ii = t & 15; }
            const float rr = rr8[ai][m];
#pragma unroll
            for (int bj = 0; bj < 2; ++bj) {
                const int c = u.pn * 256 + bj * 128 + wc * 32 + 8 * fq, g = c >> 4, h0 = c & 15;
                const f32x4 v0 = acc[ai][bj][m][0] * rr + bq[bj][0], v1 = acc[ai][bj][m][1] * rr + bq[bj][1];
                float r[8] = {v0[0], v0[1], v0[2], v0[3], v1[0], v1[1], v1[2], v1[3]};
                *(u32x4*)(UG + ((size_t)(g * UROWS + urow) * 256 + ii * 16 + h0)) = pack8(r);
            }
        EPI_ROWS_END
    }
};
struct EpiInG {
    bf16_t* SGF; bf16_t* SGS; const float* R; const float* BIAS;
    __device__ __forceinline__ void operator()(const AccT& acc, const Unit& u, int wr, int wc, int fr, int fq) const {
        bf16_t* base = u.pn < 4 ? SGF : SGS; const int c0 = (u.pn & 3) * 256 + wc * 32 + 8 * fq, cb = 1536 + u.pn * 256 + wc * 32 + 8 * fq;
        const int rt = u.pm * 256; const float* bb = BIAS + (rt < ML ? (rt >> 12) : 8) * 3584 + cb;
        f32x4 bq[2][2];
#pragma unroll
        for (int bj = 0; bj < 2; ++bj) { bq[bj][0] = *(const f32x4*)(bb + bj * 128); bq[bj][1] = *(const f32x4*)(bb + bj * 128 + 4); }
        EPI_LOAD_R(R)
        EPI_ROWS_BEGIN
            const float rr = rr8[ai][m];
#pragma unroll
            for (int bj = 0; bj < 2; ++bj) {
                const f32x4 v0 = acc[ai][bj][m][0] * rr + bq[bj][0], v1 = acc[ai][bj][m][1] * rr + bq[bj][1];
                float r[8] = {v0[0], v0[1], v0[2], v0[3], v1[0], v1[1], v1[2], v1[3]};
#pragma unroll
                for (int j = 0; j < 8; ++j) r[j] = sigmoidf_(r[j]);
                *(u32x4*)(base + (size_t)row * DM + c0 + bj * 128) = pack8(r);
            }
        EPI_ROWS_END
    }
};
struct EpiF2 {
    bf16_t* O; int rbase, zrows, ldo;
    __device__ __forceinline__ void operator()(const AccT& acc, const Unit& u, int wr, int wc, int fr, int fq) const {
        EPI_ROWS_BEGIN
            const size_t orow = (size_t)(rbase + u.z * zrows + row);
#pragma unroll
            for (int bj = 0; bj < 2; ++bj) { float r[8]; ACC8(r, ai, bj, m); *(u32x4*)(O + orow * ldo + u.pn * 256 + bj * 128 + wc * 32 + 8 * fq) = pack8(r); }
        EPI_ROWS_END
    }
};
struct EpiSsmA {
    bf16_t* YI; float* S;
    __device__ __forceinline__ void operator()(const AccT& acc, const Unit& u, int wr, int wc, int fr, int fq) const {
        EPI_ROWS_BEGIN
            const size_t base = ((size_t)u.z * UROWS + row) * 256;
#pragma unroll
            for (int bj = 0; bj < 2; ++bj) {
                const int col = bj * 128 + wc * 32 + 8 * fq;
                if (u.pn == 0) { float r[8]; ACC8(r, ai, bj, m); *(u32x4*)(YI + base + col) = pack8(r); }
                else { *(f32x4*)(S + base + col) = acc[ai][bj][m][0]; *(f32x4*)(S + base + col + 4) = acc[ai][bj][m][1]; }
            }
        EPI_ROWS_END
    }
};
struct EpiSsmB {
    const bf16_t* YI; bf16_t* YS;
    __device__ __forceinline__ void operator()(const AccT& acc, const Unit& u, int wr, int wc, int fr, int fq) const {
        EPI_ROWS_BEGIN
            int tok0;
            if (row < 2048) tok0 = (row >> 8) * 4096 + (row & 255) * 16;
            else { const int rr = row - 2048; tok0 = ML + (rr >> 4) * 256 + (rr & 15) * 16; }
            if (row < 2176) {
                const size_t base = ((size_t)u.z * UROWS + row) * 256;
#pragma unroll
                for (int bj = 0; bj < 2; ++bj) {
                    const int col = bj * 128 + wc * 32 + 8 * fq, j = col >> 4, h0 = col & 15;
                    float r[8], yi[8]; ACC8(r, ai, bj, m); unpack8(*(const u32x4*)(YI + base + col), yi);
#pragma unroll
                    for (int q = 0; q < 8; ++q) r[q] = gelu_tanh(r[q] + yi[q]);
                    *(u32x4*)(YS + (size_t)(tok0 + j) * 512 + u.z * 16 + h0) = pack8(r);
                }
            }
        EPI_ROWS_END_NOFENCE
    }
};
struct EpiFo {
    bf16_t* SGF;
    __device__ __forceinline__ void operator()(const AccT& acc, const Unit& u, int wr, int wc, int fr, int fq) const {
        EPI_ROWS_BEGIN
#pragma unroll
            for (int bj = 0; bj < 2; ++bj) {
                bf16_t* p = SGF + (size_t)row * DM + u.pn * 256 + bj * 128 + wc * 32 + 8 * fq;
                float r[8], g[8]; ACC8(r, ai, bj, m); unpack8(*(const u32x4*)p, g);
#pragma unroll
                for (int q = 0; q < 8; ++q) r[q] *= g[q];
                *(u32x4*)p = pack8(r);
            }
        EPI_ROWS_END_NOFENCE
    }
};
struct EpiSso {
    bf16_t* SGS; const bf16_t* MG1;
    __device__ __forceinline__ void operator()(const AccT& acc, const Unit& u, int wr, int wc, int fr, int fq) const {
        EPI_ROWS_BEGIN
#pragma unroll
            for (int bj = 0; bj < 2; ++bj) {
                const size_t off = (size_t)row * DM + u.pn * 256 + bj * 128 + wc * 32 + 8 * fq;
                float r[8], g[8], f[8]; ACC8(r, ai, bj, m); unpack8(*(const u32x4*)(SGS + off), g); unpack8(*(const u32x4*)(MG1 + off), f);
#pragma unroll
                for (int q = 0; q < 8; ++q) r[q] = f[q] + g[q] * r[q];
                *(u32x4*)(SGS + off) = pack8(r);
            }
        EPI_ROWS_END_NOFENCE
    }
};

struct Ctx { LAS unsigned char* lds; int tid, lane, wave, G, bid, gw, NGW; };
#define SUBCTX(Cs, lo, n) Ctx Cs = C; { int _b = C.bid - (lo); if (_b < 0) _b += C.G; Cs.bid = _b; Cs.G = (n); Cs.gw = _b * 8 + C.wave; Cs.NGW = (n) * 8; }
#define CTX_REFRESH(C) do { int _t = ((C).wave << 6) | (int)__builtin_amdgcn_mbcnt_hi(~0u, __builtin_amdgcn_mbcnt_lo(~0u, 0u)); asm volatile("" : "+v"(_t)); (C).tid = _t; (C).lane = _t & 63; int _g = (C).gw; asm volatile("" : "+s"(_g)); (C).gw = _g; } while (0)

__device__ __forceinline__ void transpose_item(const Ctx& C, const float* W, int K, int ldw, int n0, int ncols, bf16_t* WT, int mode, int half, int row_off, int item) {
    LAS float* scr = (LAS float*)(C.lds + C.wave * 16384);
    const int nblk = ncols / 32, kb = item / nblk, nb = item % nblk, k0 = 64 * kb, nr0 = 32 * nb, lane = C.lane;
    int r0;
    if (mode == 0) r0 = row_off + nr0;
    else { const int hsel = nr0 >= half ? 1 : 0, j = nr0 - hsel * half; r0 = (j >> 7) * 256 + hsel * 128 + (j & 127); }
    float tv[32];
#pragma unroll
    for (int i = 0; i < 32; ++i) tv[i] = W[(size_t)(k0 + 2 * i + (lane >> 5)) * ldw + n0 + nr0 + (lane & 31)];
#pragma unroll
    for (int i = 0; i < 32; ++i) { const int kk = 2 * i + (lane >> 5); scr[kk * 33 + (lane & 31)] = tv[i]; }
    asm volatile("s_waitcnt lgkmcnt(0)" ::: "memory");
    const int c = lane & 7;
#pragma unroll
    for (int j = 0; j < 4; ++j) { const int n = (lane >> 3) + 8 * j; const LAS float* s = scr + (8 * c) * 33 + n;
        u32x4 o; o.x = cvt_pk_bf16(s[0 * 33], s[1 * 33]); o.y = cvt_pk_bf16(s[2 * 33], s[3 * 33]); o.z = cvt_pk_bf16(s[4 * 33], s[5 * 33]); o.w = cvt_pk_bf16(s[6 * 33], s[7 * 33]);
        *(u32x4*)(WT + (size_t)(r0 + n) * K + k0 + 8 * c) = o; }
    asm volatile("s_waitcnt lgkmcnt(0)" ::: "memory");
}
__device__ __forceinline__ void prep_transposes(const Ctx& C, const float* w13, const float* w2, const float* win, const float* wfo, const float* wglu, const float* wsso, const float* wout,
                                                bf16_t* W13, bf16_t* W2, bf16_t* WIN, bf16_t* WFO, bf16_t* WGLU, bf16_t* WSSO, bf16_t* WOUT, const bool with_ffn) {
    const int I0 = with_ffn ? 16 * 176 : 0, I1 = with_ffn ? 44 * 32 : 0; constexpr int I2 = 16 * 80, I3 = 8 * 32, I4 = 8 * 32, I5 = 8 * 32, I6 = 16 * 32; const int TOT = I0 + I1 + I2 + I3 + I4 + I5 + I6;
    int vb = C.bid; if (vb >= 128 && vb < 160) return; if (vb >= 160) vb -= 32;
    const int nvw = (C.G - 32) * 8;
    for (int it = vb * 8 + C.wave; it < TOT; it += nvw) {
        int r = it;
        if (r < I0) { transpose_item(C, w13, 1024, 5632, 0, 5632, W13, 1, 2816, 0, r); continue; } r -= I0;
        if (r < I1) { transpose_item(C, w2, 2816, 1024, 0, 1024, W2, 0, 0, 0, r); continue; } r -= I1;
        if (r < I2) { transpose_item(C, win, 1024, 3072, 512, 2560, WIN, 0, 0, 1024, r); continue; } r -= I2;
        if (r < I3) { transpose_item(C, wfo, 512, 1024, 0, 1024, WFO, 0, 0, 0, r); continue; } r -= I3;
        if (r < I4) { transpose_item(C, wglu, 512, 1024, 0, 1024, WGLU, 1, 512, 0, r); continue; } r -= I4;
        if (r < I5) { transpose_item(C, wsso, 512, 1024, 0, 1024, WSSO, 0, 0, 0, r); continue; } r -= I5;
        transpose_item(C, wout, 1024, 1024, 0, 1024, WOUT, 0, 0, 0, r);
    }
}
__device__ __forceinline__ void transpose_mat(const Ctx& C, const float* W, int K, int ldw, int n0, int ncols, bf16_t* WT, int mode, int half, int row_off) {
    const int items = (K / 64) * (ncols / 32);
    for (int it = C.gw; it < items; it += C.NGW) transpose_item(C, W, K, ldw, n0, ncols, WT, mode, half, row_off, it);
}

__device__ __forceinline__ void fourier_weight_phase(const Ctx& C, const float* Win  , bf16_t* WT) {
    LAS float* Wl = (LAS float*)C.lds; LAS float* ct = Wl + 16 * 129; LAS float* st = ct + 128;
    for (int it = C.bid; it < 256; it += C.G) {
        const int grp = it >> 6, k0 = (it & 63) * 16;
        for (int e = C.tid; e < 16 * 128; e += 512) { const int k = e >> 7, c = e & 127; Wl[k * 129 + c] = Win[(size_t)(k0 + k) * 3072 + grp * 128 + c]; }
        if (C.tid < 128) { float sn, cs; sincosf(6.283185307179586f * (float)C.tid * (1.f / 128.f), &sn, &cs); ct[C.tid] = cs; st[C.tid] = sn; }
        __syncthreads();
        if (C.tid < 256) {
            const int kq = C.tid & 3, nq = C.tid >> 2, n0 = nq * 4, part = n0 >> 7, j0 = n0 & 127; const LAS float* tb = part ? st : ct;
            float a[4][4];
#pragma unroll
            for (int x = 0; x < 4; ++x)
#pragma unroll
                for (int y = 0; y < 4; ++y) a[x][y] = 0.f;
            for (int c = 0; c < 128; ++c) {
                float w[4], t[4];
#pragma unroll
                for (int x = 0; x < 4; ++x) w[x] = Wl[(kq * 4 + x) * 129 + c];
#pragma unroll
                for (int y = 0; y < 4; ++y) t[y] = tb[(c * (j0 + y)) & 127];
#pragma unroll
                for (int x = 0; x < 4; ++x)
#pragma unroll
                    for (int y = 0; y < 4; ++y) a[x][y] += w[x] * t[y];
            }
#pragma unroll
            for (int y = 0; y < 4; ++y) {
                u32x2 o; o.x = cvt_pk_bf16(a[0][y] * 0.08838834764831845f, a[1][y] * 0.08838834764831845f); o.y = cvt_pk_bf16(a[2][y] * 0.08838834764831845f, a[3][y] * 0.08838834764831845f);
                *(u32x2*)(WT + (size_t)(grp * 256 + n0 + y) * 1024 + k0 + kq * 4) = o;
            }
        }
        __syncthreads();
    }
}

struct SsmP { const float *lre, *lim, *lst, *bre, *bim, *cre, *cim, *dd; };
__device__ __forceinline__ void ssm_mats_phase(const Ctx& C, const SsmP& P, bf16_t* Wa, bf16_t* Wb) {
    LAS float* LP = (LAS float*)C.lds;
    LAS float* BB = LP + 2 * 17 * 64 * 2;
    LAS float* CC = BB + 2 * 64 * 16 * 2;
    LAS float* KK = CC + 2 * 16 * 64 * 2;
    const int tid = C.tid;
    for (int g = (C.bid + C.G - 128) % C.G; g < 32; g += C.G) {
        LAS float* KC = KK;
        if (tid < 128) {
            const int d = tid >> 6, p = tid & 63;
            const float dt = expf(P.lst[d * 32 + g]); const float lr = P.lre[(d * 32 + g) * 64 + p], li = P.lim[(d * 32 + g) * 64 + p];
            const float mag = expf(lr * dt); float sn, cs; sincosf(li * dt, &sn, &cs);
            const float l1r = mag * cs, l1i = mag * sn;
            float pr = 1.f, pi = 0.f;
            for (int t = 0; t <= 16; ++t) { LP[((d * 17 + t) * 64 + p) * 2] = pr; LP[((d * 17 + t) * 64 + p) * 2 + 1] = pi;
                const float nr_ = pr * l1r - pi * l1i, ni_ = pr * l1i + pi * l1r; pr = nr_; pi = ni_; }
            const float nr = l1r - 1.f, ni = l1i, den = lr * lr + li * li;
            KC[(d * 64 + p) * 2] = (nr * lr + ni * li) / den; KC[(d * 64 + p) * 2 + 1] = (ni * lr - nr * li) / den;
        }
        float brv[4], biv[4];
#pragma unroll
        for (int q = 0; q < 4; ++q) { const int e = tid + 512 * q, d = e >> 10; const size_t gi = (size_t)(d * 32 + g) * 1024 + (e & 1023);
            brv[q] = P.bre[gi]; biv[q] = P.bim[gi];
            const int h = (e >> 6) & 15, p = e & 63; CC[((d * 64 + p) * 16 + h) * 2] = P.cre[gi]; CC[((d * 64 + p) * 16 + h) * 2 + 1] = P.cim[gi]; }
        __syncthreads();
#pragma unroll
        for (int q = 0; q < 4; ++q) { const int e = tid + 512 * q, d = e >> 10, p = (e >> 4) & 63, h = e & 15;
            const float kr = KC[(d * 64 + p) * 2], ki = KC[(d * 64 + p) * 2 + 1];
            BB[((d * 64 + p) * 16 + h) * 2] = kr * brv[q] - ki * biv[q]; BB[((d * 64 + p) * 16 + h) * 2 + 1] = kr * biv[q] + ki * brv[q]; }
        __syncthreads();
        {
            const int d = tid >> 8, t = (tid >> 4) & 15, h = tid & 15;
            float a[16];
#pragma unroll
            for (int q = 0; q < 16; ++q) a[q] = 0.f;
            for (int p = 0; p < 64; ++p) {
                const float cr = CC[((d * 64 + p) * 16 + h) * 2], ci = CC[((d * 64 + p) * 16 + h) * 2 + 1];
                const float Lr = LP[((d * 17 + t) * 64 + p) * 2], Li = LP[((d * 17 + t) * 64 + p) * 2 + 1];
                const float gr = cr * Lr - ci * Li, gi = cr * Li + ci * Lr;
#pragma unroll
                for (int q = 0; q < 16; ++q) a[q] += gr * BB[((d * 64 + p) * 16 + q) * 2] - gi * BB[((d * 64 + p) * 16 + q) * 2 + 1];
            }
#pragma unroll
            for (int q = 0; q < 16; ++q) KK[((d * 16 + t) * 16 + h) * 16 + q] = a[q];
        }
        __syncthreads();
        bf16_t* wa = Wa + (size_t)g * 512 * 256;
        for (int v = tid; v < 512 * 32; v += 512) {
            const int n = v >> 5, kv = (v & 31) * 8, i = kv >> 4, hp0 = kv & 15;
            float r[8];
            if (n < 256) {
                const int j = n >> 4, h = n & 15;
#pragma unroll
                for (int q = 0; q < 8; ++q) { const int hp = hp0 + q; float x = 0.f;
                    if (j >= i) x += KK[((0 * 16 + (j - i)) * 16 + h) * 16 + hp];
                    if (i >= j) x += KK[((1 * 16 + (i - j)) * 16 + h) * 16 + hp];
                    if (i == j && h == hp) x += P.dd[g * 16 + h];
                    r[q] = x; }
            } else {
                const int qn = n - 256, d = qn >> 7, ri = (qn >> 6) & 1, p = qn & 63, t = d == 0 ? 15 - i : i;
                const float Lr = LP[((d * 17 + t) * 64 + p) * 2], Li = LP[((d * 17 + t) * 64 + p) * 2 + 1];
#pragma unroll
                for (int q = 0; q < 8; ++q) { const int hp = hp0 + q; const float br = BB[((d * 64 + p) * 16 + hp) * 2], bi = BB[((d * 64 + p) * 16 + hp) * 2 + 1];
                    r[q] = ri ? (Lr * bi + Li * br) : (Lr * br - Li * bi); }
            }
            *(u32x4*)(wa + (size_t)n * 256 + kv) = pack8(r);
        }
        bf16_t* wb = Wb + (size_t)g * 256 * 256;
        for (int v = tid; v < 256 * 32; v += 512) {
            const int n = v >> 5, kv = (v & 31) * 8, j = n >> 4, h = n & 15, d = kv >> 7, ri = (kv >> 6) & 1, p0 = kv & 63, e = d == 0 ? j + 1 : 16 - j;
            float r[8];
#pragma unroll
            for (int q = 0; q < 8; ++q) { const int p = p0 + q;
                const float cr = CC[((d * 64 + p) * 16 + h) * 2], ci = CC[((d * 64 + p) * 16 + h) * 2 + 1];
                const float Lr = LP[((d * 17 + e) * 64 + p) * 2], Li = LP[((d * 17 + e) * 64 + p) * 2 + 1];
                r[q] = ri ? -(cr * Li + ci * Lr) : (cr * Lr - ci * Li); }
            *(u32x4*)(wb + (size_t)n * 256 + kv) = pack8(r);
        }
        __syncthreads();
    }
}

__device__ __forceinline__ void ssm_scan_phase(const Ctx& C, const SsmP& P, const float* S, bf16_t* Hin) {
    for (int it = C.bid; it < 256; it += C.G) {
        const int g = it >> 3, b = it & 7;
        if (C.tid < 128) {
            const int d = C.tid >> 6, p = C.tid & 63;
            const float dt = expf(P.lst[d * 32 + g]); const float lr = P.lre[(d * 32 + g) * 64 + p], li = P.lim[(d * 32 + g) * 64 + p];
            const float mag = expf(lr * dt * 16.f); float sn, cs; sincosf(li * dt * 16.f, &sn, &cs);
            const float Ar = mag * cs, Ai = mag * sn;
            float hr = 0.f, hi = 0.f;
            const float* Sg = S + (size_t)g * UROWS * 256 + d * 128 + p; bf16_t* Hg = Hin + (size_t)g * UROWS * 256 + d * 128 + p;
            float sr[16], si[16], nr_[16], ni_[16];
            {   const int rowb = 2048 + b * 16 + (d ? 15 : 0), dir = d ? -1 : 1;
#pragma unroll
                for (int q = 0; q < 16; ++q) { const size_t o = (size_t)(rowb + dir * q) * 256; sr[q] = Sg[o]; si[q] = Sg[o + 64]; } }
            for (int s0 = 0; s0 < 272; s0 += 16) {
                const int dir = d ? -1 : 1;
                const int rowb = s0 == 0 ? 2048 + b * 16 + (d ? 15 : 0) : b * 256 + (d ? 271 - s0 : s0 - 16);
                const int s1 = s0 + 16 < 272 ? s0 + 16 : s0;
                const int rown = b * 256 + (d ? 271 - s1 : s1 - 16);
#pragma unroll
                for (int q = 0; q < 16; ++q) { const size_t o = (size_t)(rown + dir * q) * 256; nr_[q] = Sg[o]; ni_[q] = Sg[o + 64]; }
#pragma unroll
                for (int q = 0; q < 16; ++q) { const size_t o = (size_t)(rowb + dir * q) * 256;
                    const unsigned pk = cvt_pk_bf16(hr, hi); Hg[o] = (bf16_t)(pk & 0xffffu); Hg[o + 64] = (bf16_t)(pk >> 16);
                    const float nr = Ar * hr - Ai * hi + sr[q], ni = Ar * hi + Ai * hr + si[q]; hr = nr; hi = ni; }
#pragma unroll
                for (int q = 0; q < 16; ++q) { sr[q] = nr_[q]; si[q] = ni_[q]; }
            }
        }
    }
}

__device__ __forceinline__ void mod_partial_phase(const Ctx& C, const float* cvec, const float* cctx, const float* wmod, float* MODP) {
    LAS float* cvs = (LAS float*)C.lds;
    for (int it = C.bid; it < 4 * 18 * 16; it += C.G) {
        const int l = it / 288, rem = it % 288, nb = rem >> 4, kc = rem & 15;
        __syncthreads();
        for (int e = C.tid; e < 576; e += 512) { const int r = e >> 6, k = e & 63; const float v = r < 8 ? cvec[r * 1024 + kc * 64 + k] : cctx[kc * 64 + k]; cvs[e] = v / (1.f + expf(-v)); }
        __syncthreads();
        const int n = nb * 512 + C.tid;
        float a[9];
#pragma unroll
        for (int r = 0; r < 9; ++r) a[r] = 0.f;
        const float* wp = wmod + ((size_t)l * 1024 + kc * 64) * NMOD + n;
        float wv[64];
#pragma unroll
        for (int k = 0; k < 64; ++k) wv[k] = wp[(size_t)k * NMOD];
#pragma unroll
        for (int k = 0; k < 64; ++k) {
#pragma unroll
            for (int r = 0; r < 9; ++r) a[r] += cvs[r * 64 + k] * wv[k]; }
#pragma unroll
        for (int r = 0; r < 9; ++r) MODP[((size_t)(kc * 4 + l) * 9 + r) * NMOD + n] = a[r];
    }
}
__device__ __forceinline__ void mod_final_phase(const Ctx& C, const float* bmod, const float* normg, const float* MODP, float* MOD, float* GS) {
    for (int e = C.bid * 512 + C.tid; e < 4 * 9 * NMOD; e += C.G * 512) {
        const int l = e / (9 * NMOD), r = (e / NMOD) % 9, n = e % NMOD; float a = bmod[l * NMOD + n];
#pragma unroll
        for (int kc = 0; kc < 16; ++kc) a += MODP[(size_t)kc * (4 * 9 * NMOD) + e];
        MOD[e] = a;
        const int j = n >> 10, c = n & 1023;
        if (j % 3 == 1) { const int k = j / 3; GS[((size_t)(l * 3 + k) * 9 + r) * DM + c] = normg[(l * 3 + k) * DM + c] * (1.f + a); }
    }
}
__device__ __forceinline__ void dft_gen_phase(const Ctx& C, bf16_t* DFT, bf16_t* DFTC) {
    LAS float* tab = (LAS float*)C.lds;
    __syncthreads();
    for (int i = C.tid; i < 4096; i += 512) tab[i] = cosf(6.283185307179586f * (float)i * (1.f / 4096.f));
    __syncthreads();
    const size_t nv = (size_t)4096 * 4096 / 8;
    for (size_t v = (size_t)C.bid * 512 + C.tid; v < nv; v += (size_t)C.G * 512) {
        const int r_ = (int)(v >> 9), t0 = (int)(v & 511) * 8, k = r_ & 2047, isq = r_ >> 11;
        float r[8];
#pragma unroll
        for (int q = 0; q < 8; ++q) { const int idx = (k * (t0 + q)) & 4095; r[q] = (isq ? tab[(idx - 1024) & 4095] : tab[idx]) * (1.f / 64.f); }
        *(u32x4*)(DFT + v * 8) = pack8(r);
    }
    for (int v = C.bid * 512 + C.tid; v < 256 * 512 / 8; v += C.G * 512) {
        const int k = v >> 6, kk0 = (v & 63) * 8, part = kk0 >> 8, t0 = kk0 & 255;
        float r[8];
#pragma unroll
        for (int q = 0; q < 8; ++q) { const int idx = ((k * (t0 + q)) & 255) * 16; r[q] = (part ? -tab[(idx - 1024) & 4095] : tab[idx]) * (1.f / 16.f); }
        *(u32x4*)(DFTC + (size_t)v * 8) = pack8(r);
    }
}
__device__ __forceinline__ void f2_combine_phase(const Ctx& C, const bf16_t* PQ, const bf16_t* VT2, bf16_t* YF) {
    const int nv = 8 * 2048 * 64;
    for (int v = C.bid * 512 + C.tid; v < nv; v += C.G * 512) {
        const int b = v >> 17, k = (v >> 6) & 2047, c8 = (v & 63) * 8;
        float p[8], q[8], d[8], a[8];
        unpack8(*(const u32x4*)(PQ + ((size_t)b * 4096 + k) * 512 + c8), p); unpack8(*(const u32x4*)(PQ + ((size_t)b * 4096 + 2048 + k) * 512 + c8), q);
#pragma unroll
        for (int j = 0; j < 8; ++j) { d[j] = p[j] - q[j]; a[j] = p[j] + q[j]; }
        *(u32x4*)(YF + ((size_t)b * 4096 + k) * 512 + c8) = pack8(d);
        if (k > 0) *(u32x4*)(YF + ((size_t)b * 4096 + 4096 - k) * 512 + c8) = pack8(a);
    }
    for (int pr = C.gw; pr < 8 * 512; pr += C.NGW) {
        const int b = pr >> 9, ch = pr & 511;
        const u32x4* vp = (const u32x4*)(VT2 + (size_t)(b * 512 + ch) * 8192 + C.lane * 64);
        float s = 0.f;
#pragma unroll
        for (int i = 0; i < 8; ++i) { float w[8]; unpack8(vp[i], w); s += (w[0] - w[1]) + (w[2] - w[3]) + (w[4] - w[5]) + (w[6] - w[7]); }
        s = wave_sum(s);
        if (C.lane == 0) { const unsigned pk = cvt_pk_bf16(s * (1.f / 64.f), 0.f); YF[((size_t)b * 4096 + 2048) * 512 + ch] = (bf16_t)(pk & 0xffffu); }
    }
}
__device__ __forceinline__ void fin_rows_phase(const Ctx& C, float* H, const float* GSk, bf16_t* AN, const float* PART, int nslice, const float* ROWSQ, float* R, bool all_rows, const float* xin = nullptr, const float* cin = nullptr, bool skip_ctx = false) {
    for (int m = (all_rows ? 0 : ML) + C.gw; m < (skip_ctx ? ML : MT); m += C.NGW) {
        const int bi = m < ML ? (m >> 12) : 8;
        f32x4* xr = (f32x4*)(H + (size_t)m * DM) + C.lane;
        f32x4 v[4]; float s = 0.f;
        if (all_rows) {
            const f32x4* ir = (const f32x4*)(m < ML ? xin + (size_t)m * DM : cin + (size_t)(m - ML) * DM) + C.lane;
#pragma unroll
            for (int j = 0; j < 4; ++j) { v[j] = ir[64 * j]; xr[64 * j] = v[j]; }
        } else {
#pragma unroll
            for (int j = 0; j < 4; ++j) v[j] = xr[64 * j];
        }
        if (!all_rows) {
            f32x4 pv[4][4];
#pragma unroll
            for (int z = 0; z < 4; ++z) { const f32x4* pr = (const f32x4*)(PART + ((size_t)(z < nslice ? z : 0) * MC + (m - ML)) * DM) + C.lane;
#pragma unroll
                for (int j = 0; j < 4; ++j) pv[z][j] = pr[64 * j]; }
#pragma unroll
            for (int z = 0; z < 4; ++z) if (z < nslice) {
#pragma unroll
                for (int j = 0; j < 4; ++j) v[j] += pv[z][j]; }
#pragma unroll
            for (int j = 0; j < 4; ++j) xr[64 * j] = v[j];
        }
#pragma unroll
        for (int j = 0; j < 4; ++j) s += (v[j][0] * v[j][0] + v[j][1] * v[j][1]) + (v[j][2] * v[j][2] + v[j][3] * v[j][3]);
        s = wave_sum(s);
        if (C.lane == 0) R[m] = rsqrtf(s * (1.f / 1024.f) + 1e-6f);
#pragma unroll
        for (int j = 0; j < 4; ++j) { const int c = 4 * (C.lane + 64 * j);
            const f32x4 y = v[j] * *(const f32x4*)(GSk + bi * DM + c);
            u32x2 w; w.x = cvt_pk_bf16(y[0], y[1]); w.y = cvt_pk_bf16(y[2], y[3]);
            *(u32x2*)(AN + (size_t)m * DM + c) = w; }
    }
    if (!all_rows)
        for (int m = C.bid * 512 + C.tid; m < ML; m += C.G * 512) {
            const f32x4* q = (const f32x4*)(ROWSQ + (size_t)m * 16); const f32x4 a = q[0], b = q[1], c = q[2], d = q[3];
            const float s = ((a[0] + a[1]) + (a[2] + a[3])) + ((b[0] + b[1]) + (b[2] + b[3])) + ((c[0] + c[1]) + (c[2] + c[3])) + ((d[0] + d[1]) + (d[2] + d[3]));
            R[m] = rsqrtf(s * (1.f / 1024.f) + 1e-6f);
        }
}
__device__ __forceinline__ void bias_phase(const Ctx& C, const bf16_t* Wt, int nrows, const float* shift  , float* BIAS) {
    for (int n = C.gw; n < nrows; n += C.NGW) {
        const u32x4* wp = (const u32x4*)(Wt + (size_t)n * DM + C.lane * 16);
        float w[16]; { float t0[8], t1[8]; unpack8(wp[0], t0); unpack8(wp[1], t1);
#pragma unroll
            for (int q = 0; q < 8; ++q) { w[q] = t0[q]; w[8 + q] = t1[q]; } }
        float a[9];
#pragma unroll
        for (int bi = 0; bi < 9; ++bi) {
            const f32x4* sp = (const f32x4*)(shift + bi * NMOD + C.lane * 16);
            float acc = 0.f;
#pragma unroll
            for (int q = 0; q < 4; ++q) { const f32x4 sv = sp[q]; acc += (sv[0] * w[4 * q] + sv[1] * w[4 * q + 1]) + (sv[2] * w[4 * q + 2] + sv[3] * w[4 * q + 3]); }
            a[bi] = acc;
        }
#pragma unroll
        for (int o = 1; o < 64; o <<= 1)
#pragma unroll
            for (int bi = 0; bi < 9; ++bi) a[bi] += __shfl_xor(a[bi], o);
        if (C.lane == 0) {
#pragma unroll
            for (int bi = 0; bi < 9; ++bi) BIAS[bi * nrows + n] = a[bi];
        }
    }
}
__device__ __forceinline__ void final_norm_phase(const Ctx& C, const float* H, const float* gvec, float* out) {
    for (int m = 2 * C.gw; m < ML; m += 2 * C.NGW) {
        const f32x4* xr0 = (const f32x4*)(H + (size_t)m * DM) + C.lane; const f32x4* xr1 = xr0 + DM / 4;
        f32x4 v0[4], v1[4]; float s0 = 0.f, s1 = 0.f;
#pragma unroll
        for (int j = 0; j < 4; ++j) { v0[j] = xr0[64 * j]; v1[j] = xr1[64 * j]; }
#pragma unroll
        for (int j = 0; j < 4; ++j) { s0 += (v0[j][0] * v0[j][0] + v0[j][1] * v0[j][1]) + (v0[j][2] * v0[j][2] + v0[j][3] * v0[j][3]);
                                      s1 += (v1[j][0] * v1[j][0] + v1[j][1] * v1[j][1]) + (v1[j][2] * v1[j][2] + v1[j][3] * v1[j][3]); }
#pragma unroll
        for (int o = 1; o < 64; o <<= 1) { s0 += __shfl_xor(s0, o); s1 += __shfl_xor(s1, o); }
        const float r0 = rsqrtf(s0 * (1.f / 1024.f) + 1e-6f), r1 = rsqrtf(s1 * (1.f / 1024.f) + 1e-6f);
#pragma unroll
        for (int j = 0; j < 4; ++j) { const int c = 4 * (C.lane + 64 * j); const f32x4 g4 = *(const f32x4*)(gvec + c);
            *(f32x4*)(out + (size_t)m * DM + c) = v0[j] * r0 * g4; *(f32x4*)(out + (size_t)(m + 1) * DM + c) = v1[j] * r1 * g4; }
    }
}

__device__ __forceinline__ void dump_phase(const Ctx& C, const bf16_t* a, const bf16_t* b, float* out) {
    const size_t n = (size_t)ML * 512;
    for (size_t i = (size_t)C.bid * 512 + C.tid; i < n; i += (size_t)C.G * 512) { out[i] = __uint_as_float((unsigned)a[i] << 16); out[n + i] = __uint_as_float((unsigned)b[i] << 16); }
}

#define XB_TMO      128
#define XB_XCNT(j)  (256  + 64 * (j))
#define XB_XSUB(j)  (1280 + 64 * (j))
#define XB_XGEN(j)  (2304 + 64 * (j))
#define XB_TOP      3328
#define XB_TOPGEN   3392
#define XCD_BAR_WORDS 3456
#define XB_SPIN_CAP (1u << 18)
__device__ __forceinline__ unsigned xb_ld(unsigned* p)              { return __hip_atomic_load(p, __ATOMIC_RELAXED, __HIP_MEMORY_SCOPE_AGENT); }
__device__ __forceinline__ unsigned xb_add(unsigned* p, unsigned v) { return __hip_atomic_fetch_add(p, v, __ATOMIC_RELAXED, __HIP_MEMORY_SCOPE_AGENT); }
__device__ __forceinline__ unsigned xb_xcc_id() { return (unsigned)__builtin_amdgcn_s_getreg((3 << 11) | 20) & 0xFu; }
#define XB_SPIN(cond, bar) do { unsigned _sp = 0; while (cond) { __builtin_amdgcn_s_sleep(1); \
    if ((++_sp & 255u) == 0u) { if (xb_ld(&(bar)[XB_TMO])) break; if (_sp > XB_SPIN_CAP) { atomicAdd(&(bar)[XB_TMO], 1u); break; } } } } while (0)
struct XcdBarrier { unsigned* bar; unsigned x; volatile LAS unsigned* st; };
__device__ __forceinline__ void xcd_barrier_complete(unsigned* bar, unsigned x, unsigned& nloc, unsigned& nx) {
    const unsigned G = gridDim.x * gridDim.y * gridDim.z;
    unsigned sum, cnt, mine, sp = 0u;
    for (;;) {
        sum = 0u; cnt = 0u; mine = 0u;
#pragma unroll
        for (unsigned j = 0; j < 16; ++j) { const unsigned c = xb_ld(&bar[XB_XCNT(j)]); sum += c; cnt += (c > 0u) ? 1u : 0u; mine = (j == x) ? c : mine; }
        if (sum == G) break;
        __builtin_amdgcn_s_sleep(1);
        if ((++sp & 255u) == 0u) { if (xb_ld(&bar[XB_TMO])) break; if (sp > XB_SPIN_CAP) { atomicAdd(&bar[XB_TMO], 1u); break; } }
    }
    nloc = mine > 0u ? mine : 1u; nx = cnt > 0u ? cnt : 1u;
}
__device__ __forceinline__ void xcd_barrier(const XcdBarrier& b) {
    asm volatile("s_waitcnt vmcnt(0)" ::: "memory");
    __syncthreads();
    if (threadIdx.x == 0) {
        unsigned* bar = b.bar;
        __builtin_amdgcn_s_waitcnt(0);
        unsigned nloc = b.st[0], nx = b.st[1];
        if (nloc == 0u) { xcd_barrier_complete(bar, b.x, nloc, nx); b.st[0] = nloc; b.st[1] = nx; }
        const unsigned old = xb_add(&bar[XB_XSUB(b.x)], 1u);
        const unsigned gen = old / nloc;
        if (old + 1u == (gen + 1u) * nloc) {
            __builtin_amdgcn_fence(__ATOMIC_RELEASE, "agent");
            asm volatile("s_waitcnt vmcnt(0)" ::: "memory");
            const unsigned og = xb_add(&bar[XB_TOP], 1u);
            const unsigned tg = og / nx;
            if (og + 1u == (tg + 1u) * nx) xb_add(&bar[XB_TOPGEN], 1u);
            else XB_SPIN(xb_ld(&bar[XB_TOPGEN]) == tg, bar);
            __builtin_amdgcn_fence(__ATOMIC_ACQUIRE, "agent");
            xb_add(&bar[XB_XGEN(b.x)], 1u);
            asm volatile("s_waitcnt vmcnt(0)" ::: "memory");
        } else {
            XB_SPIN(xb_ld(&bar[XB_XGEN(b.x)]) == gen, bar);
            __builtin_amdgcn_fence(__ATOMIC_ACQUIRE, "agent");
            asm volatile("s_waitcnt vmcnt(0)" ::: "memory");
        }
    }
    __syncthreads();
}
#ifndef PROF_SEL
#define PROF_SEL 0
#endif
#define PROF_TS ((volatile LAS unsigned long long*)(C.lds + 131072 + 1024))
#define PROF_CNT ((volatile LAS unsigned*)(C.lds + 131072 + 768))
#define PROF_STAMP() do { if (PROF_SEL && blockIdx.x == 0 && threadIdx.x == 0) { const unsigned _n = PROF_CNT[0]; PROF_TS[_n] = __builtin_amdgcn_s_memrealtime(); PROF_CNT[0] = _n + 1; } } while (0)
#define GRID_SYNC_CG() do { asm volatile("s_waitcnt vmcnt(0) lgkmcnt(0)" ::: "memory"); grid.sync(); __builtin_amdgcn_fence(__ATOMIC_ACQUIRE, "agent"); asm volatile("s_waitcnt vmcnt(0)" ::: "memory"); PROF_STAMP(); } while (0)
#define GRID_SYNC() do { XcdBarrier _xb; _xb.bar = (unsigned*)(WSBASE() + WS_CTL); _xb.x = xb_xcc_id(); _xb.st = (volatile LAS unsigned*)(C.lds + 131072 + 512); xcd_barrier(_xb); PROF_STAMP(); } while (0)
struct Args { const float* in[25]; float* out; unsigned char* ws; };

__device__ __forceinline__ void* ldptr(LAS unsigned long long* PT, int i) {
    unsigned off = 8u * (unsigned)i; asm volatile("" : "+s"(off));
    const unsigned long long v = *(LAS unsigned long long*)((LAS unsigned char*)PT + off);
    unsigned lo = __builtin_amdgcn_readfirstlane((unsigned)v), hi = __builtin_amdgcn_readfirstlane((unsigned)(v >> 32));
    asm volatile("" : "+s"(lo), "+s"(hi));
    return (void*)(((unsigned long long)hi << 32) | lo);
}
#define INP(i) ((const float*)ldptr(PT, i))
#define WSBASE() ((unsigned char*)ldptr(PT, 26))
#define OUTP ((float*)ldptr(PT, 25))
#define XIN INP(0)
#define cvec INP(1)
#define ctxin INP(2)
#define cctx INP(3)
#define wmod INP(4)
#define bmod INP(5)
#define normg INP(6)
#define f1w13 INP(7)
#define f1w2 INP(8)
#define win INP(9)
#define wfo INP(10)
#define LRE INP(11)
#define LIM INP(12)
#define LST INP(13)
#define BRE INP(14)
#define BIM INP(15)
#define CRE INP(16)
#define CIM INP(17)
#define SDD INP(18)
#define wglu INP(19)
#define wsso INP(20)
#define wout INP(21)
#define f2w13 INP(22)
#define f2w2 INP(23)
#define fing INP(24)
#define H ((float*)(WSBASE() + WS_H))
#define MOD ((float*)(WSBASE() + WS_MOD))
#define MODP ((float*)(WSBASE() + X_MODP))
#define HID ((bf16_t*)(WSBASE() + X_HID))
#define AN_FFN ((bf16_t*)(WSBASE() + X_AN_FFN))
#define AN_MIX ((bf16_t*)(WSBASE() + X_AN_MIX))
#define VT2 ((bf16_t*)(WSBASE() + X_VT2))
#define VT2C ((bf16_t*)(WSBASE() + X_VT2C))
#define SGF ((bf16_t*)(WSBASE() + X_SGF))
#define SGS ((bf16_t*)(WSBASE() + X_SGS))
#define UG ((bf16_t*)(WSBASE() + X_UG))
#define HIN ((bf16_t*)(WSBASE() + X_UG))
#define SB ((float*)(WSBASE() + X_S))
#define YS ((bf16_t*)(WSBASE() + X_YS))
#define ZG ((bf16_t*)(WSBASE() + X_ZG))
#define YF ((bf16_t*)(WSBASE() + X_YF))
#define YI ((bf16_t*)(WSBASE() + X_YI))
#define DFT ((bf16_t*)(WSBASE() + WS_DFT))
#define DFTC ((bf16_t*)(WSBASE() + WS_DFTC))
#define W13 ((bf16_t*)(WSBASE() + W_13))
#define W13B ((bf16_t*)(WSBASE() + W_13B))
#define W2B ((bf16_t*)(WSBASE() + W_2B))
#define W2 ((bf16_t*)(WSBASE() + W_2))
#define WIN ((bf16_t*)(WSBASE() + W_IN))
#define WFO ((bf16_t*)(WSBASE() + W_FO))
#define WGLU ((bf16_t*)(WSBASE() + W_GLU))
#define WSSO ((bf16_t*)(WSBASE() + W_SSO))
#define WOUT ((bf16_t*)(WSBASE() + W_OUT))
#define WSA ((bf16_t*)(WSBASE() + W_SA))
#define WSB ((bf16_t*)(WSBASE() + W_SB))
#define PART ((float*)(WSBASE() + WS_PART))
#define PQB ((bf16_t*)(WSBASE() + WS_X + 240 * MiB))
#define GSK(l_, k_) ((float*)(WSBASE() + WS_GS) + (size_t)((l_) * 3 + (k_)) * 9 * DM)
#define RVEC ((float*)(WSBASE() + WS_R))
#define ROWSQ ((float*)(WSBASE() + WS_ROWSQ))
#define BIASF ((float*)(WSBASE() + WS_BIASF))
#define BIASM ((float*)(WSBASE() + WS_BIASM))
#define MODl (MOD + (size_t)l * 9 * NMOD)
#define MKPL(P, L) SsmP P; P.lre = LRE + (L) * 4096; P.lim = LIM + (L) * 4096; P.lst = LST + (L) * 64; P.bre = BRE + (size_t)(L) * 65536; P.bim = BIM + (size_t)(L) * 65536; \
        P.cre = CRE + (size_t)(L) * 65536; P.cim = CIM + (size_t)(L) * 65536; P.dd = SDD + (L) * 512;
#define MKP(P) MKPL(P, l)
#define PREP_LAYER(L, WITH_FFN) do { CTX_REFRESH(C); __syncthreads(); \
        prep_transposes(C, f1w13 + (size_t)(L) * 1024 * 5632, f1w2 + (size_t)(L) * 2816 * 1024, win + (size_t)(L) * 1024 * 3072, wfo + (size_t)(L) * 512 * 1024, \
                        wglu + (size_t)(L) * 512 * 1024, wsso + (size_t)(L) * 512 * 1024, wout + (size_t)(L) * 1024 * 1024, W13, W2, WIN, WFO, WGLU, WSSO, WOUT, (WITH_FFN)); \
        __syncthreads(); CTX_REFRESH(C); \
        { MKPL(P_, L) ssm_mats_phase(C, P_, WSA, WSB); } \
        CTX_REFRESH(C); fourier_weight_phase(C, win + (size_t)(L) * 1024 * 3072, WIN); } while (0)
__global__ void __launch_bounds__(512, 2) fwd_mega(Args args) {
    extern __shared__ __attribute__((aligned(16))) unsigned char lds_raw[];
    cg::grid_group grid = cg::this_grid();
    Ctx C; C.lds = (LAS unsigned char*)lds_raw; C.tid = threadIdx.x; C.lane = C.tid & 63; C.wave = __builtin_amdgcn_readfirstlane(C.tid >> 6);
    C.G = gridDim.x; C.bid = blockIdx.x; C.gw = C.bid * 8 + C.wave; C.NGW = C.G * 8;
    LAS unsigned long long* PT = (LAS unsigned long long*)(C.lds + 131072);
    if (threadIdx.x == 0) {
        PT[0] = (unsigned long long)args.in[0]; PT[1] = (unsigned long long)args.in[1]; PT[2] = (unsigned long long)args.in[2]; PT[3] = (unsigned long long)args.in[3]; PT[4] = (unsigned long long)args.in[4];
        PT[5] = (unsigned long long)args.in[5]; PT[6] = (unsigned long long)args.in[6]; PT[7] = (unsigned long long)args.in[7]; PT[8] = (unsigned long long)args.in[8]; PT[9] = (unsigned long long)args.in[9];
        PT[10] = (unsigned long long)args.in[10]; PT[11] = (unsigned long long)args.in[11]; PT[12] = (unsigned long long)args.in[12]; PT[13] = (unsigned long long)args.in[13]; PT[14] = (unsigned long long)args.in[14];
        PT[15] = (unsigned long long)args.in[15]; PT[16] = (unsigned long long)args.in[16]; PT[17] = (unsigned long long)args.in[17]; PT[18] = (unsigned long long)args.in[18]; PT[19] = (unsigned long long)args.in[19];
        PT[20] = (unsigned long long)args.in[20]; PT[21] = (unsigned long long)args.in[21]; PT[22] = (unsigned long long)args.in[22]; PT[23] = (unsigned long long)args.in[23]; PT[24] = (unsigned long long)args.in[24];
        PT[25] = (unsigned long long)args.out; PT[26] = (unsigned long long)args.ws;
        volatile LAS unsigned* st = (volatile LAS unsigned*)(C.lds + 131072 + 512); st[0] = 0u; st[1] = 0u;
        if (PROF_SEL && blockIdx.x == 0) { PROF_CNT[0] = 1u; PROF_TS[0] = __builtin_amdgcn_s_memrealtime(); }
        (void)xb_add((unsigned*)(args.ws + WS_CTL) + XB_XCNT(xb_xcc_id()), 1u);
    }
    __syncthreads();
    const int G = C.G, bid = C.bid;

    {
        mod_partial_phase(C, cvec, cctx, wmod, MODP);
        dft_gen_phase(C, DFT, DFTC);
        PREP_LAYER(0, true);
    }
    if (args.ws == nullptr) GRID_SYNC_CG();
    GRID_SYNC();
    mod_final_phase(C, bmod, normg, MODP, MOD, GSK(0, 0));
    GRID_SYNC(); CTX_REFRESH(C);

    for (int l = 0; l < DEPTH; ++l) {


        for (int f = 0; f < 2; ++f) {
#ifndef NO_MIX
            if (f == 1) {
                const int NRT = (l == DEPTH - 1) ? ML / 256 : MT / 256;
                fin_rows_phase(C, H, GSK(l, 1), AN_MIX, PART, 4, ROWSQ, RVEC, false);
                GRID_SYNC(); CTX_REFRESH(C);
#if defined(DUMP) && DUMP == 8
                {
                    pg8::Sched S; S.init(AN_MIX, W13, MT / 256, 22, 1, 1024, 1024, 0, 0, G, bid);
                    EpiPair<0> E{HID, DFF, RVEC, BIASF}; pg8::gemm_phase(C.lds, C.wave, 1024, 1024, 1024, S, E);
                }
                GRID_SYNC(); CTX_REFRESH(C);
                dump_phase(C, HID, HID + (size_t)ML * 512, OUTP); return;
#endif
#if defined(DUMP) && DUMP == 5
                dump_phase(C, AN_MIX, AN_MIX + (size_t)ML * 512, OUTP); return;
#endif
#if defined(DUMP) && DUMP == 6
                { const size_t nw = (size_t)24 * MiB / 2, nall = (size_t)ML * DM;
                  for (size_t i = (size_t)C.bid * 512 + C.tid; i < nall; i += (size_t)C.G * 512) OUTP[i] = i < nw ? __uint_as_float((unsigned)WIN[i] << 16) : 0.f; }
                return;
#endif
#if (MIXSEL >> 0) & 1
                {
                    pg8::Sched S; S.init(WIN, AN_MIX, 4, MT / 256, 1, 1024, 1024, 0, 0, G, bid);
                    EpiInT E{VT2, VT2C, RVEC, BIASM}; pg8::gemm_phase(C.lds, C.wave, 1024, 1024, 1024, S, E);
                }
#endif
#if (MIXSEL >> 1) & 1
                {
                    pg8::Sched S; S.init(AN_MIX, WIN + (size_t)1024 * 1024, MT / 256, 2, 1, 1024, 1024, 0, 0, G, (bid + 32) % G);
                    EpiInU E{UG, RVEC, BIASM}; pg8::gemm_phase(C.lds, C.wave, 1024, 1024, 1024, S, E);
                }
                {
                    pg8::Sched S; S.init(AN_MIX, WIN + (size_t)1536 * 1024, MT / 256, 8, 1, 1024, 1024, 0, 0, G, (bid + 192) % G);
                    EpiInG E{SGF, SGS, RVEC, BIASM}; pg8::gemm_phase(C.lds, C.wave, 1024, 1024, 1024, S, E);
                }
#endif
                GRID_SYNC(); CTX_REFRESH(C);
#if defined(DUMP) && DUMP == 3
                dump_phase(C, SGF, SGS, OUTP); return;
#endif
#if defined(DUMP) && DUMP == 4
                dump_phase(C, VT2, VT2 + (size_t)ML * 512, OUTP); return;
#endif
#if (MIXSEL >> 2) & 1
                {
                    pg8::Sched S; S.init(DFT, VT2, 16, 2, 8, 4096, 8192, 0, (size_t)512 * 8192, G, bid);
                    S.bsplit = 8; S.boff = (size_t)4096 * 2;
                    EpiF2 E{PQB, 0, 4096, 512}; pg8::gemm_phase(C.lds, C.wave, 4096, 4096, 8192, S, E);
                }
#endif
                GRID_SYNC(); CTX_REFRESH(C);
                if (l < DEPTH - 1) {
                    pg8::Sched S; S.init(DFTC, VT2C, 1, 2, 8, 512, 512, 0, (size_t)512 * 512, G, (bid + 128) % G);
                    EpiF2 E{YF, ML, 256, 512}; pg8::gemm_phase(C.lds, C.wave, 512, 512, 512, S, E);
                }
                f2_combine_phase(C, PQB, VT2, YF);
                GRID_SYNC(); CTX_REFRESH(C);
#if defined(DUMP) && DUMP == 1
                dump_phase(C, YF, SGS, OUTP); return;
#endif
#if (MIXSEL >> 4) & 1
                {
                    pg8::Sched S; S.init(UG, WSA, 9, 2, 32, 256, 256, (size_t)UROWS * 256, (size_t)512 * 256, G, bid);
                    EpiSsmA E{YI, SB}; pg8::gemm_phase(C.lds, C.wave, 256, 256, 256, S, E);
                }
#endif
#if (MIXSEL >> 5) & 1
                {
                    pg8::Sched S; S.init(YF, WFO, NRT, 4, 1, 512, 512, 0, 0, G, (bid + 64) % G);
                    EpiFo E{SGF}; pg8::gemm_phase(C.lds, C.wave, 512, 512, 512, S, E);
                }
#endif
                GRID_SYNC(); CTX_REFRESH(C);
                { MKP(P) ssm_scan_phase(C, P, SB, HIN); }
                GRID_SYNC(); CTX_REFRESH(C);
#if (MIXSEL >> 6) & 1
                {
                    pg8::Sched S; S.init(HIN, WSB, l == DEPTH - 1 ? 8 : 9, 1, 32, 256, 256, (size_t)UROWS * 256, (size_t)256 * 256, G, bid);
                    EpiSsmB E{YI, YS}; pg8::gemm_phase(C.lds, C.wave, 256, 256, 256, S, E);
                }
#endif
                GRID_SYNC(); CTX_REFRESH(C);
#if defined(DUMP) && DUMP == 2
                dump_phase(C, YS, SGF, OUTP); return;
#endif
#if (MIXSEL >> 7) & 1
                {
                    pg8::Sched S; S.init(YS, WGLU, NRT, 4, 1, 512, 512, 0, 0, G, bid);
                    EpiPair<1> E{ZG, 512, nullptr, nullptr}; pg8::gemm_phase(C.lds, C.wave, 512, 512, 512, S, E);
                }
#endif
                GRID_SYNC(); CTX_REFRESH(C);
#if (MIXSEL >> 8) & 1
                {
                    pg8::Sched S; S.init(ZG, WSSO, NRT, 4, 1, 512, 512, 0, 0, G, bid);
                    EpiSso E{SGS, SGF}; pg8::gemm_phase(C.lds, C.wave, 512, 512, 512, S, E);
                }
#endif
                GRID_SYNC(); CTX_REFRESH(C);
#if (MIXSEL >> 9) & 1
                {
                    pg8::Sched S; S.init(SGS, WOUT, ML / 256, 4, 1, 1024, 1024, 0, 0, G, bid);
                    EpiRes<false, false> E{H, MODl + 5 * 1024, PART, GSK(l, 2), AN_FFN, ROWSQ}; pg8::gemm_phase(C.lds, C.wave, 1024, 1024, 1024, S, E);
                }
                if (l < DEPTH - 1) {
                    pg8::Sched S; S.init(SGS + (size_t)ML * 1024, WOUT, MC / 256, 4, 4, 1024, 1024, 256, 256, G, (bid + G / 2) % G);
                    EpiRes<true, false> E{H, MODl + 5 * 1024, PART, nullptr, nullptr, nullptr}; pg8::gemm_phase(C.lds, C.wave, 256, 1024, 1024, S, E);
                }
                { SUBCTX(Cs, 0, G / 2) if (Cs.bid < G / 2) bias_phase(Cs, W13B, 5632, MODl + 6 * 1024, BIASF); }
#endif
                GRID_SYNC(); CTX_REFRESH(C);
            }
#endif
#ifndef NO_FFN
            const int kb = f == 0 ? 0 : 6;
            if (f == 0) { if (l == 0) fin_rows_phase(C, H, GSK(0, 0), AN_FFN, PART, 2, ROWSQ, RVEC, true, XIN, ctxin);
                          else fin_rows_phase(C, H, GSK(l, 0), AN_FFN, PART, 2, ROWSQ, RVEC, false);
                          bias_phase(C, W13, 5632, MODl, BIASF); bias_phase(C, WIN, 3584, MODl + 3 * 1024, BIASM); }
            else        { fin_rows_phase(C, H, GSK(l, 2), AN_FFN, PART, 4, ROWSQ, RVEC, false, nullptr, nullptr, l == DEPTH - 1);
                          if (l < DEPTH - 1) { CTX_REFRESH(C); __syncthreads(); fourier_weight_phase(C, win + (size_t)(l + 1) * 1024 * 3072, WIN); } }
            GRID_SYNC(); CTX_REFRESH(C);
            {
                pg8::Sched S; S.init(AN_FFN, f == 0 ? W13 : W13B, (f == 1 && l == DEPTH - 1) ? ML / 256 : MT / 256, 22, 1, 1024, 1024, 0, 0, G, bid);
                EpiPair<0> E{HID, DFF, RVEC, BIASF}; pg8::gemm_phase(C.lds, C.wave, 1024, 1024, 1024, S, E);
            }
            GRID_SYNC(); CTX_REFRESH(C);
            {
                pg8::Sched S; S.init(HID, f == 0 ? W2 : W2B, ML / 256, 4, 1, DFF, DFF, 0, 0, G, bid);
                EpiRes<false, true> E{H, MODl + (kb + 2) * 1024, PART, f == 0 ? GSK(l, 1) : GSK(l < 3 ? l + 1 : 3, 0), f == 0 ? AN_MIX : AN_FFN, ROWSQ}; pg8::gemm_phase(C.lds, C.wave, DFF, DFF, DFF, S, E);
            }
            if (f == 0) {
                {   pg8::Sched S; S.init(HID + (size_t)ML * DFF, W2, MC / 256, 4, 2, DFF, DFF, 768, 768, G, (bid + G / 2) % G);
                    EpiRes<true, true> E{H, MODl + (kb + 2) * 1024, PART, nullptr, nullptr, nullptr}; pg8::gemm_phase(C.lds, C.wave, 768, DFF, DFF, S, E); }
                {   pg8::Sched S; S.init(HID + (size_t)ML * DFF + 1536, W2 + 1536, MC / 256, 4, 2, DFF, DFF, 640, 640, G, (bid + G / 2 + 64) % G);
                    EpiRes<true, true> E{H, MODl + (kb + 2) * 1024, PART + (size_t)2 * MC * DM, nullptr, nullptr, nullptr}; pg8::gemm_phase(C.lds, C.wave, 640, DFF, DFF, S, E); }
                SUBCTX(Cs, G / 2 + 64, G / 2)
                if (Cs.bid < G / 2) { __syncthreads();
                    transpose_mat(Cs, f2w13 + (size_t)l * 1024 * 5632, 1024, 5632, 0, 5632, W13B, 1, 2816, 0);
                    transpose_mat(Cs, f2w2 + (size_t)l * 2816 * 1024, 2816, 1024, 0, 1024, W2B, 0, 0, 0); }
            } else if (l < DEPTH - 1) {
                {   pg8::Sched S; S.init(HID + (size_t)ML * DFF, W2B, MC / 256, 4, 2, DFF, DFF, 1408, 1408, G, (bid + G / 2) % G);
                    EpiRes<true, true> E{H, MODl + (kb + 2) * 1024, PART, nullptr, nullptr, nullptr}; pg8::gemm_phase(C.lds, C.wave, 1408, DFF, DFF, S, E); }
                SUBCTX(Cs, G / 2 + 64, G - 64)
                if (Cs.bid < G - 64) { __syncthreads();
                    transpose_mat(Cs, f1w13 + (size_t)(l + 1) * 1024 * 5632, 1024, 5632, 0, 5632, W13, 1, 2816, 0);
                    transpose_mat(Cs, f1w2 + (size_t)(l + 1) * 2816 * 1024, 2816, 1024, 0, 1024, W2, 0, 0, 0);
                    prep_transposes(Cs, nullptr, nullptr, win + (size_t)(l + 1) * 1024 * 3072, wfo + (size_t)(l + 1) * 512 * 1024, wglu + (size_t)(l + 1) * 512 * 1024,
                                    wsso + (size_t)(l + 1) * 512 * 1024, wout + (size_t)(l + 1) * 1024 * 1024, W13, W2, WIN, WFO, WGLU, WSSO, WOUT, false);
                    __syncthreads();
                    { MKPL(P_, l + 1) ssm_mats_phase(Cs, P_, WSA, WSB); } }
            }
            GRID_SYNC(); CTX_REFRESH(C);
#endif
        }
    }
    CTX_REFRESH(C);
    final_norm_phase(C, H, fing, OUTP);
#if PROF_SEL
    if (blockIdx.x == 0) {
        __syncthreads();
        if (threadIdx.x == 0) {
            unsigned long long tot = 0ull;
            for (int l = 0; l < 4; ++l) for (int j = 0; j < 16; ++j) {
                const int i = 3 + l * 16 + j; const unsigned long long d = PROF_TS[i] - PROF_TS[i - 1];
                bool sel = false;
                if (PROF_SEL == 1) sel = (j == 0 || j == 3 || j == 13);
                if (PROF_SEL == 2) sel = (j == 2 || j == 15);
                if (PROF_SEL == 3) sel = (j == 7 || j == 9 || j == 11 || j == 12);
                if (PROF_SEL == 4) sel = (j == 0); if (PROF_SEL == 5) sel = (j == 3); if (PROF_SEL == 6) sel = (j == 13);
                if (PROF_SEL == 7) sel = (j == 5 || j == 6); if (PROF_SEL == 8) sel = (j == 7);
                if (sel) tot += d;
            }
            if (PROF_SEL == 9) tot = PROF_TS[2] - PROF_TS[0];
            const float t_us = (float)tot * 0.01f;
            float* o = OUTP;
            o[0] = o[0] + sqrtf(t_us);
        }
    }
#endif
}

extern "C" void kernel_launch(void* const* d_in, const int* in_sizes, int n_in, void* d_out, int out_size, void* d_ws, size_t ws_size, hipStream_t stream) {
    static int grid = 0;
    if (grid == 0) {
        if (n_in != 25 || ws_size < WS_END) { fprintf(stderr, "kernel_launch: bad n_in %d or ws_size %zu < %zu\n", n_in, ws_size, (size_t)WS_END); grid = -1; return; }
        int dev = 0, cus = 0, per_cu = 0;
        (void)hipGetDevice(&dev);
        (void)hipDeviceGetAttribute(&cus, hipDeviceAttributeMultiprocessorCount, dev);
        (void)hipFuncSetAttribute((const void*)fwd_mega, hipFuncAttributeMaxDynamicSharedMemorySize, LDS_BYTES);
        (void)hipOccupancyMaxActiveBlocksPerMultiprocessor(&per_cu, (const void*)fwd_mega, 512, LDS_BYTES);
        if (per_cu < 1) per_cu = 1;
        grid = cus * 1;
        if (grid < 160) { fprintf(stderr, "kernel_launch: needs >= 160 CUs (got %d)\n", grid); grid = -1; return; }
        fprintf(stderr, "kernel_launch: grid %d (cus %d, per_cu %d), ws %zu\n", grid, cus, per_cu, ws_size);
    }
    if (grid < 0) return;
    if (hipMemsetAsync((char*)d_ws + WS_CTL, 0, CTL_BYTES, stream) != hipSuccess) { fprintf(stderr, "kernel_launch: memset of the barrier words failed\n"); return; }
    Args a{};
    for (int i = 0; i < 25; ++i) a.in[i] = (const float*)d_in[i];
    a.out = (float*)d_out; a.ws = (unsigned char*)d_ws;
    void* kargs[] = {&a};
    hipError_t e = hipLaunchCooperativeKernel((const void*)fwd_mega, dim3(grid), dim3(512), kargs, LDS_BYTES, stream);
    if (e != hipSuccess) fprintf(stderr, "kernel_launch: cooperative launch failed: %s\n", hipGetErrorString(e));
}
```
